# Optimizing an MI355X kernel written in HIP

```python
import jax, jax.numpy as jnp
from jax import lax
import numpy as np

D_MODEL = 1024
BATCH = 4
SEQ = 4096
DEPTH = 1
DEC_BATCH = 128
DEC_SEQ = 1
PAST_LEN = 8192
PAGE_SIZE = 128

HEAD_DIM = 64
N_Q_HEADS = 8
N_KV_HEADS = 2
GQA_GROUP = N_Q_HEADS // N_KV_HEADS
WINDOW = 128
ROT_DIM = HEAD_DIM // 4
ROPE_THETA = 500000.0
N_HGRN_HEADS = 8
HGRN_DK = 64
HGRN_DV = 64
HGRN_CHUNK = 64
D_ATTN = N_Q_HEADS * HEAD_DIM
D_KV = N_KV_HEADS * HEAD_DIM
D_HGRN_K = N_HGRN_HEADS * HGRN_DK
D_HGRN = N_HGRN_HEADS * HGRN_DV
D_MIX = D_ATTN + D_HGRN
IN_SPLITS = (D_ATTN, D_KV, D_KV, D_HGRN_K, D_HGRN_K, D_HGRN, D_HGRN)
IN_COLS = sum(IN_SPLITS)
D_FF = 2816
EPS = 1e-6
NEG_INF = -1e30

kernel_name = "hymba_swa_sink_hgrn2_macaron_step"


def rms_norm(x, g):
    xf = x.astype(jnp.float32)
    r = xf * lax.rsqrt(jnp.mean(xf * xf, axis=-1, keepdims=True) + EPS)
    return (r * g.astype(jnp.float32)).astype(x.dtype)


def half_step_ffn(x, g_pre, g_post, w_gu, w_down):
    h = rms_norm(x, g_pre)
    gate, up = jnp.split(h @ w_gu, 2, axis=-1)
    y = (jax.nn.silu(gate) * up) @ w_down
    return x + 0.5 * rms_norm(y, g_post)


def partial_rope(x, pos):
    half = ROT_DIM // 2
    inv = ROPE_THETA ** (-jnp.arange(half, dtype=jnp.float32) / half)
    ang = pos[:, None] * inv[None, :]
    cos = jnp.cos(ang)[:, None, :]
    sin = jnp.sin(ang)[:, None, :]
    xf = x.astype(jnp.float32)
    x1, x2, rest = xf[..., :half], xf[..., half:ROT_DIM], xf[..., ROT_DIM:]
    out = jnp.concatenate([x1 * cos - x2 * sin, x2 * cos + x1 * sin, rest], axis=-1)
    return out.astype(x.dtype)


def sink_softmax(s, mask, sink):
    s = jnp.where(mask, s, NEG_INF)
    m = jnp.maximum(jnp.max(s, axis=-1, keepdims=True), sink)
    p = jnp.exp(s - m)
    denom = jnp.sum(p, axis=-1, keepdims=True) + jnp.exp(sink - m)
    return p / denom


def mixer_inputs(proj, pos, lb):
    B, T, _ = proj.shape
    offs = [int(o) for o in np.cumsum(IN_SPLITS)[:-1]]
    q, k, v, hq, hf, hi, hg = jnp.split(proj, offs, axis=-1)
    q = partial_rope(q.reshape(B, T, N_Q_HEADS, HEAD_DIM), pos)
    k = partial_rope(k.reshape(B, T, N_KV_HEADS, HEAD_DIM), pos)
    v = v.reshape(B, T, N_KV_HEADS, HEAD_DIM)
    hq = hq.reshape(B, T, N_HGRN_HEADS, HGRN_DK).astype(jnp.float32) * (HGRN_DK ** -0.5)
    lbh = lb.reshape(N_HGRN_HEADS, HGRN_DK)
    f = lbh + (1.0 - lbh) * jax.nn.sigmoid(hf.reshape(B, T, N_HGRN_HEADS, HGRN_DK).astype(jnp.float32))
    logf = jnp.log(f)
    hk = 1.0 - f
    hv = hi.reshape(B, T, N_HGRN_HEADS, HGRN_DV).astype(jnp.float32)
    hg = hg.reshape(B, T, N_HGRN_HEADS, HGRN_DV)
    return q, k, v, hq, hk, logf, hv, hg


def swa_prompt(q, k, v, sinks):
    B, T, _, _ = q.shape
    nb = T // WINDOW
    qb = q.reshape(B, nb, WINDOW, N_KV_HEADS, GQA_GROUP, HEAD_DIM)
    pad = jnp.zeros((B, WINDOW, N_KV_HEADS, HEAD_DIM), k.dtype)
    kp = jnp.concatenate([pad, k], axis=1)
    vp = jnp.concatenate([pad.astype(v.dtype), v], axis=1)
    kb = jnp.concatenate([kp[:, :T].reshape(B, nb, WINDOW, N_KV_HEADS, HEAD_DIM),
                          k.reshape(B, nb, WINDOW, N_KV_HEADS, HEAD_DIM)], axis=2)
    vb = jnp.concatenate([vp[:, :T].reshape(B, nb, WINDOW, N_KV_HEADS, HEAD_DIM),
                          v.reshape(B, nb, WINDOW, N_KV_HEADS, HEAD_DIM)], axis=2)
    s = jnp.einsum('bnqhgd,bnkhd->bnhgqk', qb, kb).astype(jnp.float32) * (HEAD_DIM ** -0.5)
    i = jnp.arange(WINDOW)[:, None]
    j = jnp.arange(2 * WINDOW)[None, :]
    rel = i + WINDOW - j
    band = (rel >= 0) & (rel < WINDOW)
    valid = band[None] & ((jnp.arange(nb)[:, None, None] > 0) | (j[None] >= WINDOW))
    sink = sinks.astype(jnp.float32).reshape(1, 1, N_KV_HEADS, GQA_GROUP, 1, 1)
    p = sink_softmax(s, valid[None, :, None, None], sink)
    o = jnp.einsum('bnhgqk,bnkhd->bnqhgd', p.astype(vb.dtype), vb)
    keep = min(WINDOW, T)
    return o.reshape(B, T, D_ATTN), k[:, T - keep:], v[:, T - keep:]


def swa_sample(q, k, v, win_k, win_v, sinks):
    B, T, _, _ = q.shape
    W = win_k.shape[1]
    keys = jnp.concatenate([win_k.astype(k.dtype), k], axis=1)
    vals = jnp.concatenate([win_v.astype(v.dtype), v], axis=1)
    qg = q.reshape(B, T, N_KV_HEADS, GQA_GROUP, HEAD_DIM)
    s = jnp.einsum('bqhgd,bkhd->bhgqk', qg, keys).astype(jnp.float32) * (HEAD_DIM ** -0.5)
    kpos = jnp.concatenate([PAST_LEN - W + jnp.arange(W), PAST_LEN + jnp.arange(T)])
    qpos = PAST_LEN + jnp.arange(T)
    rel = qpos[:, None] - kpos[None, :]
    valid = (rel >= 0) & (rel < WINDOW)
    sink = sinks.astype(jnp.float32).reshape(1, N_KV_HEADS, GQA_GROUP, 1, 1)
    p = sink_softmax(s, valid, sink)
    o = jnp.einsum('bhgqk,bkhd->bqhgd', p.astype(vals.dtype), vals)
    return o.reshape(B, T, D_ATTN), keys[:, T:], vals[:, T:]


def hgrn2_chunk(S, q, k, logf, v):
    C = q.shape[1]
    G = jnp.cumsum(logf, axis=1)
    o_inter = jnp.einsum('bchk,bhkv->bchv', q * jnp.exp(G), S)
    tri = jnp.tril(jnp.ones((C, C), dtype=bool))
    diff = G[:, :, None] - G[:, None, :]
    decay = jnp.where(tri[None, :, :, None, None], jnp.exp(jnp.minimum(diff, 0.0)), 0.0)
    A = jnp.einsum('bthk,bshk,btshk->bhts', q, k, decay)
    o_intra = jnp.einsum('bhts,bshv->bthv', A, v)
    GC = G[:, -1]
    kd = k * jnp.exp(GC[:, None] - G)
    S_new = jnp.exp(GC)[..., None] * S + jnp.einsum('bshk,bshv->bhkv', kd, v)
    return S_new, o_inter + o_intra


def hgrn2_prompt(hq, hk, logf, hv):
    B, T = hq.shape[:2]
    C = min(HGRN_CHUNK, T)
    nc = T // C

    def to_chunks(a):
        return a.reshape(B, nc, C, *a.shape[2:]).swapaxes(0, 1)

    S0 = jnp.zeros((B, N_HGRN_HEADS, HGRN_DK, HGRN_DV), jnp.float32)
    S, o = lax.scan(lambda S, xs: hgrn2_chunk(S, *xs), S0,
                    (to_chunks(hq), to_chunks(hk), to_chunks(logf), to_chunks(hv)))
    return o.swapaxes(0, 1).reshape(B, T, N_HGRN_HEADS, HGRN_DV), S


def mixer_output(att, ho, hg, out_g, w_o):
    B, T, _ = att.shape
    hn = rms_norm(ho, out_g) * jax.nn.silu(hg.astype(jnp.float32))
    cat = jnp.concatenate([att, hn.reshape(B, T, D_HGRN).astype(att.dtype)], axis=-1)
    return cat @ w_o


def setup_inputs(seed: int = 0) -> dict:
    key = jax.random.key(seed)
    ks = jax.random.split(key, 24)
    f32 = jnp.float32

    def w(k, shape, fan_in):
        return jax.random.normal(k, shape, f32) * fan_in ** -0.5

    def gain(k, shape):
        return 1.0 + 0.05 * jax.random.normal(k, shape, f32)

    win_keep = min(WINDOW, PAST_LEN)
    return {
        "x_prompt": jax.random.normal(ks[0], (BATCH, SEQ, D_MODEL), f32),
        "x_sample": jax.random.normal(ks[1], (DEC_BATCH, DEC_SEQ, D_MODEL), f32),
        "cache_win_k": jax.random.normal(ks[2], (DEPTH, DEC_BATCH, win_keep, N_KV_HEADS, HEAD_DIM), f32),
        "cache_win_v": jax.random.normal(ks[3], (DEPTH, DEC_BATCH, win_keep, N_KV_HEADS, HEAD_DIM), f32),
        "state_hgrn": 0.3 * jax.random.normal(ks[4], (DEPTH, DEC_BATCH, N_HGRN_HEADS, HGRN_DK, HGRN_DV), f32),
        "ffn1_pre_g": gain(ks[5], (DEPTH, D_MODEL)),
        "ffn1_post_g": gain(ks[6], (DEPTH, D_MODEL)),
        "ffn1_w_gu": w(ks[7], (DEPTH, D_MODEL, 2 * D_FF), D_MODEL),
        "ffn1_w_down": w(ks[8], (DEPTH, D_FF, D_MODEL), D_FF),
        "mix_pre_g": gain(ks[9], (DEPTH, D_MODEL)),
        "mix_post_g": gain(ks[10], (DEPTH, D_MODEL)),
        "w_in": w(ks[11], (DEPTH, D_MODEL, IN_COLS), D_MODEL),
        "attn_sinks": 0.5 * jax.random.normal(ks[12], (DEPTH, N_Q_HEADS), f32),
        "hgrn_lb": 0.1 * jax.random.normal(ks[13], (DEPTH + 1, D_HGRN_K), f32),
        "hgrn_out_g": gain(ks[14], (DEPTH, HGRN_DV)),
        "w_out": w(ks[15], (DEPTH, D_MIX, D_MODEL), D_MIX),
        "ffn2_pre_g": gain(ks[16], (DEPTH, D_MODEL)),
        "ffn2_post_g": gain(ks[17], (DEPTH, D_MODEL)),
        "ffn2_w_gu": w(ks[18], (DEPTH, D_MODEL, 2 * D_FF), D_MODEL),
        "ffn2_w_down": w(ks[19], (DEPTH, D_FF, D_MODEL), D_FF),
    }


def reference(x_prompt, x_sample, cache_win_k, cache_win_v, state_hgrn,
              ffn1_pre_g, ffn1_post_g, ffn1_w_gu, ffn1_w_down,
              mix_pre_g, mix_post_g, w_in, attn_sinks, hgrn_lb, hgrn_out_g, w_out,
              ffn2_pre_g, ffn2_post_g, ffn2_w_gu, ffn2_w_down):
    T_p = x_prompt.shape[1]
    T_s = x_sample.shape[1]
    pos_p = jnp.arange(T_p, dtype=jnp.float32)
    pos_s = PAST_LEN + jnp.arange(T_s, dtype=jnp.float32)
    lb_all = jnp.cumsum(jax.nn.softmax(hgrn_lb.astype(jnp.float32), axis=0), axis=0)

    xp, xs = x_prompt, x_sample
    wk_p, wv_p, S_p_all, wk_s, wv_s, S_s_all = [], [], [], [], [], []
    for l in range(DEPTH):
        xp = half_step_ffn(xp, ffn1_pre_g[l], ffn1_post_g[l], ffn1_w_gu[l], ffn1_w_down[l])
        xs = half_step_ffn(xs, ffn1_pre_g[l], ffn1_post_g[l], ffn1_w_gu[l], ffn1_w_down[l])

        q, k, v, hq, hk, logf, hv, hg = mixer_inputs(rms_norm(xp, mix_pre_g[l]) @ w_in[l], pos_p, lb_all[l])
        att, nk, nv = swa_prompt(q, k, v, attn_sinks[l])
        ho, S_p = hgrn2_prompt(hq, hk, logf, hv)
        xp = xp + rms_norm(mixer_output(att, ho, hg, hgrn_out_g[l], w_out[l]), mix_post_g[l])
        wk_p.append(nk)
        wv_p.append(nv)
        S_p_all.append(S_p.astype(x_prompt.dtype))

        q, k, v, hq, hk, logf, hv, hg = mixer_inputs(rms_norm(xs, mix_pre_g[l]) @ w_in[l], pos_s, lb_all[l])
        att, nk, nv = swa_sample(q, k, v, cache_win_k[l], cache_win_v[l], attn_sinks[l])
        S_s, ho = hgrn2_chunk(state_hgrn[l].astype(jnp.float32), hq, hk, logf, hv)
        xs = xs + rms_norm(mixer_output(att, ho, hg, hgrn_out_g[l], w_out[l]), mix_post_g[l])
        wk_s.append(nk.astype(cache_win_k.dtype))
        wv_s.append(nv.astype(cache_win_v.dtype))
        S_s_all.append(S_s.astype(state_hgrn.dtype))

        xp = half_step_ffn(xp, ffn2_pre_g[l], ffn2_post_g[l], ffn2_w_gu[l], ffn2_w_down[l])
        xs = half_step_ffn(xs, ffn2_pre_g[l], ffn2_post_g[l], ffn2_w_gu[l], ffn2_w_down[l])

    return (xp, xs, jnp.stack(wk_p), jnp.stack(wv_p), jnp.stack(S_p_all),
            jnp.stack(wk_s), jnp.stack(wv_s), jnp.stack(S_s_all))
```

```cpp
#include <hip/hip_runtime.h>
#include <hip/hip_cooperative_groups.h>
#include <cstdio>
#include <cstdint>
namespace cg = cooperative_groups;
namespace pg8 {
#define PG8_LAS __attribute__((address_space(3)))
typedef unsigned short bf16_t;
typedef short bf16x8 __attribute__((ext_vector_type(8)));
typedef float f32x4 __attribute__((ext_vector_type(4)));
typedef unsigned u32x4 __attribute__((ext_vector_type(4)));
constexpr int BM = 256, BK = 64, HALF = 128, HTB = HALF * BK * 2  , STAGE_BYTES = 8 * HTB, NXCD = 8, WGM = 8;

__host__ __device__ __forceinline__ int lds_byte(int r, int c) { const int st = (r >> 4) * 2 + (c >> 5), rr = r & 15, cc = c & 31, ob = rr * 64 + cc * 2; return st * 1024 + (ob ^ (((ob >> 9) & 1) << 5)); }
__host__ __device__ __forceinline__ void stage_rc(int b, int& R, int& C) { const int st = b / 1024, sb = b % 1024, swz = sb ^ (((sb >> 9) & 1) << 5); R = (st >> 1) * 16 + swz / 64; C = (st & 1) * 32 + (swz % 64) / 2; }
__host__ __device__ __forceinline__ int perm32(int rho) { const int n = rho >> 4, i = rho & 15; return 8 * (i >> 2) + 4 * n + (i & 3); }

struct Unit { int pm, pn; };
struct Gemm { const bf16_t* A; const bf16_t* Bt; int M, N, K; };

struct StaticOrder {
    int nM, nN, nwg, G, c;
    __host__ __device__ void init(int M, int N, int G_, int c_) { nM = M / BM; nN = N / BM; nwg = nM * nN; G = G_; c = c_; }
    __host__ __device__ bool next(int i, Unit& u) const {
        const long L = (long)i * G + c; if (L >= nwg) return false;
        int wgid = (int)L; { const int q = nwg / NXCD, r = nwg % NXCD, xcd = wgid % NXCD, off = wgid / NXCD; wgid = (xcd < r ? xcd * (q + 1) : r * (q + 1) + (xcd - r) * q) + off; }
        const int nig = WGM * nN, gid = wgid / nig, fm = gid * WGM, gsz = (nM - fm) < WGM ? (nM - fm) : WGM;
        u.pm = fm + ((wgid % nig) % gsz); u.pn = (wgid % nig) / gsz; return true;
    }
    __device__ __forceinline__ void a_ready(const Unit&) const {}
    __device__ __forceinline__ void done(const Unit&) const {}
};

__device__ __forceinline__ unsigned cvt_pk_bf16(float lo, float hi) { unsigned r; asm volatile("v_cvt_pk_bf16_f32 %0, %1, %2" : "=v"(r) : "v"(lo), "v"(hi)); return r; }
typedef float f32x2 __attribute__((ext_vector_type(2)));
struct EpiBf16 {
    static constexpr bool PERM = true, AFTER_DRAIN = false;
    bf16_t* O; int ldc;
    __device__ __forceinline__ void operator()(const f32x4 (&acc)[2][2][4][2], const Unit& u, int wr, int wc, int fr, int fq) const {
        const int row0 = u.pm * BM + wr * 64 + fr; const int col0 = u.pn * BM + wc * 32 + 8 * fq;
#pragma unroll
        for (int ai = 0; ai < 2; ++ai)
#pragma unroll
            for (int m = 0; m < 4; ++m) { bf16_t* rowp = O + (size_t)(row0 + ai * HALF + m * 16) * ldc + col0;
#pragma unroll
                for (int bj = 0; bj < 2; ++bj) { const f32x4 v0 = acc[ai][bj][m][0], v1 = acc[ai][bj][m][1];
                    u32x4 w; w.x = cvt_pk_bf16(v0[0], v0[1]); w.y = cvt_pk_bf16(v0[2], v0[3]); w.z = cvt_pk_bf16(v1[0], v1[1]); w.w = cvt_pk_bf16(v1[2], v1[3]);
                    *(u32x4*)(rowp + bj * HALF) = w; } }
    }
};
__device__ __forceinline__ float silu_f(float g) { return g * __builtin_amdgcn_rcpf(1.0f + __expf(-g)); }
struct EpiSwiGLU {
    static constexpr bool PERM = true, AFTER_DRAIN = false;
    bf16_t* O; int ldc;
    __device__ __forceinline__ void operator()(const f32x4 (&acc)[2][2][4][2], const Unit& u, int wr, int wc, int fr, int fq) const {
        const int row0 = u.pm * BM + wr * 64 + fr; const int col0 = u.pn * HALF + wc * 32 + 8 * fq;
#pragma unroll
        for (int ai = 0; ai < 2; ++ai)
#pragma unroll
            for (int m = 0; m < 4; ++m) { bf16_t* rowp = O + (size_t)(row0 + ai * HALF + m * 16) * ldc + col0;
                const f32x4 g0 = acc[ai][0][m][0], g1 = acc[ai][0][m][1], u0 = acc[ai][1][m][0], u1 = acc[ai][1][m][1];
                u32x4 w;
                w.x = cvt_pk_bf16(silu_f(g0[0]) * u0[0], silu_f(g0[1]) * u0[1]); w.y = cvt_pk_bf16(silu_f(g0[2]) * u0[2], silu_f(g0[3]) * u0[3]);
                w.z = cvt_pk_bf16(silu_f(g1[0]) * u1[0], silu_f(g1[1]) * u1[1]); w.w = cvt_pk_bf16(silu_f(g1[2]) * u1[2], silu_f(g1[3]) * u1[3]);
                *(u32x4*)rowp = w; }
    }
};
struct EpiF32 {
    static constexpr bool PERM = false, AFTER_DRAIN = false;
    float* O; int ldc;
    __device__ __forceinline__ void operator()(const f32x4 (&acc)[2][2][4][2], const Unit& u, int wr, int wc, int fr, int fq) const {
        const int row0 = u.pm * BM + wr * 64 + fr; const int col0 = u.pn * BM + wc * 32 + 4 * fq;
#pragma unroll
        for (int ai = 0; ai < 2; ++ai)
#pragma unroll
            for (int m = 0; m < 4; ++m) { float* rowp = O + (size_t)(row0 + ai * HALF + m * 16) * ldc + col0;
#pragma unroll
                for (int bj = 0; bj < 2; ++bj)
#pragma unroll
                    for (int n = 0; n < 2; ++n) *(f32x4*)(rowp + bj * HALF + n * 16) = acc[ai][bj][m][n]; }
    }
};
template <class Epi, class Sched, bool ALIGN_EPI = false, bool SP2 = false>
__device__ __forceinline__ void gemm_phase(PG8_LAS unsigned char* lds, const Gemm g, const Sched& S, const Epi& E) {
    const int tid = threadIdx.x, wid = __builtin_amdgcn_readfirstlane(tid >> 6), lane = tid & 63, wr = wid >> 2, wc = wid & 3, fr = lane & 15, fq = lane >> 4;
    const int K = g.K, nt = K / BK;
    unsigned voffA[2], voffB[2];
#pragma unroll
    for (int i = 0; i < 2; ++i) { int R, C; stage_rc(tid * 16 + i * 8192, R, C); const int Rb = Epi::PERM ? ((R & ~31) + perm32(R & 31)) : R;
        voffA[i] = (unsigned)(R * K + C) * 2u; voffB[i] = (unsigned)(Rb * K + C) * 2u; }
    const size_t kstep = (size_t)(BK * 2);
    const size_t hstep = (size_t)HALF * K * 2;
    const size_t tstep = 2 * hstep;
    const unsigned ldsw = (unsigned)wid * 1024u;
    const int aoff = lds_byte(wr * 64 + fr, fq * 8), boff = lds_byte(wc * 32 + fr, fq * 8);
#define PG8_SA(b, h) (((b) * 2 + (h)) * HTB)
#define PG8_SB(b, h) ((4 + (b) * 2 + (h)) * HTB)
#define PG8_STAGE(bufoff, gbase, voff) do { _Pragma("unroll") for (int _i = 0; _i < 2; ++_i) \
        __builtin_amdgcn_global_load_lds((const unsigned*)((const char*)(gbase) + (voff)[_i]), (PG8_LAS unsigned*)(lds + (bufoff) + ldsw + _i * 8192), 16, 0, 0); } while (0)
#define PG8_LDA(dst, b, h) do { _Pragma("unroll") for (int m = 0; m < 4; ++m) _Pragma("unroll") for (int k = 0; k < 2; ++k) dst[m][k] = *(const PG8_LAS bf16x8*)(lds + PG8_SA(b, h) + aoff + m * 2048 + k * 1024); } while (0)
#define PG8_LDB(dst, b, h) do { _Pragma("unroll") for (int n = 0; n < 2; ++n) _Pragma("unroll") for (int k = 0; k < 2; ++k) dst[n][k] = *(const PG8_LAS bf16x8*)(lds + PG8_SB(b, h) + boff + n * 2048 + k * 1024); } while (0)
#define PG8_MMA(ai, bj, At, Bt) do { __builtin_amdgcn_s_setprio(1); _Pragma("unroll") for (int m = 0; m < 4; ++m) _Pragma("unroll") for (int n = 0; n < 2; ++n) _Pragma("unroll") for (int k = 0; k < 2; ++k) \
        acc[ai][bj][m][n] = __builtin_amdgcn_mfma_f32_16x16x32_bf16(Bt[n][k], At[m][k], acc[ai][bj][m][n], 0, 0, 0); __builtin_amdgcn_s_setprio(0); } while (0)
#define PG8_WAIT_V(n) asm volatile("s_waitcnt vmcnt(" #n ")" ::: "memory")
#define PG8_WAIT_L(n) asm volatile("s_waitcnt lgkmcnt(" #n ")" ::: "memory")
#define PG8_BAR __builtin_amdgcn_s_barrier()
#define PG8_SCHED __builtin_amdgcn_sched_barrier(0)
    Unit cur, nxt; int ui = 0;
    if (!S.next(0, cur)) return;
    f32x4 acc[2][2][4][2];
#pragma unroll
    for (int a = 0; a < 2; ++a)
#pragma unroll
        for (int b = 0; b < 2; ++b)
#pragma unroll
            for (int m = 0; m < 4; ++m)
#pragma unroll
                for (int n = 0; n < 2; ++n) acc[a][b][m][n] = (f32x4){0.f, 0.f, 0.f, 0.f};
    bf16x8 At[4][2], B0[2][2], B1[2][2];
    const char* cA = (const char*)g.A + (size_t)cur.pm * tstep; const char* cB = (const char*)g.Bt + (size_t)cur.pn * tstep;
    S.a_ready(cur);
    if constexpr (SP2) {
        PG8_STAGE(PG8_SB(0, 0), cB, voffB); PG8_STAGE(PG8_SB(0, 1), cB + hstep, voffB); PG8_STAGE(PG8_SA(0, 0), cA, voffA); PG8_STAGE(PG8_SA(0, 1), cA + hstep, voffA);
        if (wr == 1) PG8_BAR;
        PG8_WAIT_V(2); PG8_BAR;
        PG8_STAGE(PG8_SB(1, 0), cB + kstep, voffB); PG8_STAGE(PG8_SA(1, 0), cA + kstep, voffA); PG8_STAGE(PG8_SB(1, 1), cB + hstep + kstep, voffB);
        PG8_WAIT_V(6); PG8_BAR;
    } else {
        PG8_STAGE(PG8_SB(0, 0), cB, voffB); PG8_STAGE(PG8_SA(0, 0), cA, voffA); PG8_STAGE(PG8_SB(0, 1), cB + hstep, voffB); PG8_STAGE(PG8_SA(0, 1), cA + hstep, voffA);
        if (wr == 1) PG8_BAR;
        PG8_WAIT_V(4); PG8_BAR;
        PG8_STAGE(PG8_SB(1, 0), cB + kstep, voffB); PG8_STAGE(PG8_SA(1, 0), cA + kstep, voffA); PG8_STAGE(PG8_SB(1, 1), cB + hstep + kstep, voffB);
        PG8_WAIT_V(6); PG8_BAR;
    }
    for (;;) {
        const bool has_next = S.next(ui + 1, nxt);
        const char* nA = has_next ? (const char*)g.A + (size_t)nxt.pm * tstep : cA; const char* nB = has_next ? (const char*)g.Bt + (size_t)nxt.pn * tstep : cB;
        for (int t = 0; t < nt; t += 2) {
            const bool last = (t == nt - 2);
            const char* a1 = cA + (size_t)(t + 1) * kstep;
            const char* a2 = last ? nA : cA + (size_t)(t + 2) * kstep; const char* b2 = last ? nB : cB + (size_t)(t + 2) * kstep;
            const char* a3 = a2 + kstep; const char* b3 = b2 + kstep;
            if (last && has_next) S.a_ready(nxt);
            if constexpr (SP2) {
            PG8_LDB(B0, 0, 0); PG8_LDB(B1, 0, 1); PG8_SCHED; PG8_LDA(At, 0, 0); PG8_STAGE(PG8_SA(1, 1), a1 + hstep, voffA);
            PG8_WAIT_V(8); PG8_WAIT_L(0); PG8_BAR; PG8_MMA(0, 0, At, B0); PG8_MMA(0, 1, At, B1); PG8_BAR; PG8_SCHED;
            PG8_LDA(At, 0, 1); PG8_STAGE(PG8_SB(0, 0), b2, voffB); PG8_STAGE(PG8_SB(0, 1), b2 + hstep, voffB); PG8_STAGE(PG8_SA(0, 0), a2, voffA);
            PG8_WAIT_V(8); PG8_WAIT_L(0); PG8_BAR; PG8_MMA(1, 0, At, B0); PG8_MMA(1, 1, At, B1); PG8_BAR; PG8_SCHED;
            PG8_LDB(B0, 1, 0); PG8_LDB(B1, 1, 1); PG8_SCHED; PG8_LDA(At, 1, 0); PG8_STAGE(PG8_SA(0, 1), a2 + hstep, voffA);
            PG8_WAIT_V(8); PG8_WAIT_L(0); PG8_BAR; PG8_MMA(0, 0, At, B0); PG8_MMA(0, 1, At, B1); PG8_BAR; PG8_SCHED;
            PG8_LDA(At, 1, 1); PG8_STAGE(PG8_SB(1, 0), b3, voffB); PG8_STAGE(PG8_SB(1, 1), b3 + hstep, voffB); PG8_STAGE(PG8_SA(1, 0), a3, voffA);
            PG8_WAIT_V(8); PG8_WAIT_L(0); PG8_BAR; PG8_MMA(1, 0, At, B0); PG8_MMA(1, 1, At, B1); PG8_BAR; PG8_SCHED;
            } else {
            PG8_LDB(B0, 0, 0); PG8_SCHED; PG8_LDA(At, 0, 0); PG8_STAGE(PG8_SA(1, 1), a1 + hstep, voffA);
            PG8_WAIT_L(8); PG8_BAR; PG8_WAIT_L(0); PG8_MMA(0, 0, At, B0); PG8_BAR; PG8_SCHED;
            PG8_LDB(B1, 0, 1); PG8_STAGE(PG8_SB(0, 0), b2, voffB);
            PG8_BAR; PG8_WAIT_L(0); PG8_MMA(0, 1, At, B1); PG8_BAR;
            PG8_LDA(At, 0, 1); PG8_STAGE(PG8_SA(0, 0), a2, voffA);
            PG8_BAR; PG8_WAIT_L(0); PG8_MMA(1, 0, At, B0); PG8_BAR; PG8_SCHED;
            PG8_STAGE(PG8_SB(0, 1), b2 + hstep, voffB);
            PG8_WAIT_V(6); PG8_BAR; PG8_MMA(1, 1, At, B1); PG8_BAR;
            PG8_LDB(B0, 1, 0); PG8_SCHED; PG8_LDA(At, 1, 0); PG8_STAGE(PG8_SA(0, 1), a2 + hstep, voffA);
            PG8_WAIT_L(8); PG8_BAR; PG8_WAIT_L(0); PG8_MMA(0, 0, At, B0); PG8_BAR; PG8_SCHED;
            PG8_LDB(B1, 1, 1); PG8_STAGE(PG8_SB(1, 0), b3, voffB);
            PG8_BAR; PG8_WAIT_L(0); PG8_MMA(0, 1, At, B1); PG8_BAR;
            PG8_LDA(At, 1, 1); PG8_STAGE(PG8_SA(1, 0), a3, voffA);
            PG8_BAR; PG8_WAIT_L(0); PG8_MMA(1, 0, At, B0); PG8_BAR; PG8_SCHED;
            PG8_STAGE(PG8_SB(1, 1), b3 + hstep, voffB);
            PG8_WAIT_V(6); PG8_BAR; PG8_MMA(1, 1, At, B1); PG8_BAR;
            }
        }
        if constexpr (ALIGN_EPI) { if (wr == 0) PG8_BAR; }
        if constexpr (!Epi::AFTER_DRAIN) { E(acc, cur, wr, wc, fr, fq); S.done(cur); }
        if (!has_next) break;
#pragma unroll
        for (int a = 0; a < 2; ++a)
#pragma unroll
            for (int b = 0; b < 2; ++b)
#pragma unroll
                for (int m = 0; m < 4; ++m)
#pragma unroll
                    for (int n = 0; n < 2; ++n) acc[a][b][m][n] = (f32x4){0.f, 0.f, 0.f, 0.f};
        cur = nxt; cA = nA; cB = nB; ++ui;
        if constexpr (ALIGN_EPI) { if (wr == 1) PG8_BAR; }
    }
    PG8_WAIT_V(0);
    if constexpr (!ALIGN_EPI) { if (wr == 0) PG8_BAR; }
    PG8_BAR;
    if constexpr (Epi::AFTER_DRAIN) { E.fused(acc, cur, wr, wc, fr, fq, lds, wid, lane); S.done(cur); }
#undef PG8_SA
#undef PG8_SB
#undef PG8_STAGE
#undef PG8_LDA
#undef PG8_LDB
#undef PG8_MMA
#undef PG8_WAIT_V
#undef PG8_WAIT_L
#undef PG8_BAR
#undef PG8_SCHED
}
}

constexpr int DM = 1024, SEQ = 4096, NBATCH = 4, MPROMPT = 16384, MSAMP = 128, MTOK = 16512, MPAD = 16640, DFF = 2816, NGU = 5632, NIN = 2816;
constexpr int C_Q = 0, C_K = 512, C_V = 640, C_HQ = 768, C_HF = 1280, C_HI = 1792, C_HG = 2304;
constexpr float EPS = 1e-6f;
constexpr float LOG2E = 1.4426950408889634f;
constexpr float PAST_POS = 8192.0f;
constexpr size_t O_WKP = (size_t)MTOK * DM, O_WVP = O_WKP + 65536, O_SP = O_WVP + 65536, O_WKS = O_SP + 131072, O_WVS = O_WKS + 2097152, O_SS = O_WVS + 2097152;
constexpr size_t MiB = 1u << 20;
constexpr size_t WS_WGU1 = 1 * MiB, WS_WDN1 = 12 * MiB, WS_WIN = 18 * MiB, WS_WOUT = 24 * MiB, WS_WGU2 = 26 * MiB, WS_WDN2 = 37 * MiB;
constexpr size_t WS_LB = 43 * MiB;
constexpr size_t WS_XN = 44 * MiB;
constexpr size_t WS_ACT = 77 * MiB;
constexpr size_t WS_Y = 167 * MiB;
constexpr size_t WS_U = WS_Y, WS_D = WS_Y + 32 * MiB;
constexpr size_t WS_END = 232 * MiB;
static_assert(WS_XN + (size_t)MPAD * DM * 2 <= WS_ACT && WS_ACT + (size_t)MPAD * DFF * 2 <= WS_Y && WS_Y + (size_t)MPAD * DM * 4 <= WS_END, "ws map");

constexpr int LDS_BYTES = 147456;

#define GAS __attribute__((address_space(1)))
#define LAS __attribute__((address_space(3)))
typedef unsigned short bf16;
typedef unsigned v4u __attribute__((ext_vector_type(4)));
typedef float f32x4 __attribute__((ext_vector_type(4)));
typedef short bf16x8 __attribute__((ext_vector_type(8)));
#define LDS_WAIT() asm volatile("s_waitcnt lgkmcnt(0)" ::: "memory")
#define DI __device__ __forceinline__

DI unsigned f2bf(float f) { unsigned u = __builtin_bit_cast(unsigned, f); return (u + 0x7fffu + ((u >> 16) & 1u)) >> 16; }
DI unsigned pk2(float lo, float hi) { return f2bf(lo) | (f2bf(hi) << 16); }
DI float bf2f(unsigned short h) { return __uint_as_float(((unsigned)h) << 16); }
DI float wave_sum(float v) {
#pragma unroll
    for (int o = 1; o < 64; o <<= 1) v += __shfl_xor(v, o);
    return v;
}
DI float wave_max(float v) {
#pragma unroll
    for (int o = 1; o < 64; o <<= 1) v = fmaxf(v, __shfl_xor(v, o));
    return v;
}
DI float sigmoid_f(float x) { return __builtin_amdgcn_rcpf(1.0f + __expf(-x)); }
DI float silu2_f(float x) { return x * sigmoid_f(x); }
DI void rope_cs(float pos, int i, float& c, float& s) {
    const float inv = __builtin_amdgcn_exp2f(-(float)i * 2.3664460711655217f);
    float rev = (pos * inv) * 0.15915494309189535f;
    rev = rev - floorf(rev);
    s = __builtin_amdgcn_sinf(rev); c = __builtin_amdgcn_cosf(rev);
}
DI void unpack8(const v4u raw, float (&f)[8]) {
#pragma unroll
    for (int i = 0; i < 4; ++i) { f[2 * i] = __uint_as_float(raw[i] << 16); f[2 * i + 1] = __uint_as_float(raw[i] & 0xffff0000u); }
}
DI v4u pack8(const float (&f)[8]) { v4u o; o.x = pk2(f[0], f[1]); o.y = pk2(f[2], f[3]); o.z = pk2(f[4], f[5]); o.w = pk2(f[6], f[7]); return o; }
DI float rope_elem(const bf16* hp, int d, float pos) {
    const int i = d & 7; float c, s; rope_cs(pos, i, c, s);
    const float x1 = bf2f(hp[i]), x2 = bf2f(hp[i + 8]);
    return d < 8 ? x1 * c - x2 * s : x2 * c + x1 * s;
}

template <int MODE> DI void tr_item(const float* W, int K, int N, const float* gain, bf16* WT, LAS float* scr, int item, int lane) {
    const int nblk = N / 32, kb = item / nblk, nb = item % nblk, k0 = 64 * kb, n0 = 32 * nb;
#pragma unroll 8
    for (int i = 0; i < 32; ++i) { const int kk = 2 * i + (lane >> 5); float w = W[(size_t)(k0 + kk) * N + n0 + (lane & 31)]; if (gain) w *= gain[k0 + kk]; scr[kk * 33 + (lane & 31)] = w; }
    LDS_WAIT(); asm volatile("" ::: "memory");
    const int c = lane & 7;
#pragma unroll
    for (int j = 0; j < 4; ++j) { const int n = (lane >> 3) + 8 * j; const LAS float* s = scr + (8 * c) * 33 + n;
        v4u o; o.x = pk2(s[0 * 33], s[1 * 33]); o.y = pk2(s[2 * 33], s[3 * 33]); o.z = pk2(s[4 * 33], s[5 * 33]); o.w = pk2(s[6 * 33], s[7 * 33]);
        const int ns = n0 + n; int drow = ns;
        if (MODE == 1) drow = ns < DFF ? ((ns >> 7) * 256 + (ns & 127)) : (((ns - DFF) >> 7) * 256 + 128 + ((ns - DFF) & 127));
        *(v4u*)(WT + (size_t)drow * K + k0 + 8 * c) = o; }
    LDS_WAIT(); asm volatile("" ::: "memory");
}
DI void norm_row_to_bf16(const float* xrow, bf16* orow, int lane) {
    const f32x4* xr = (const f32x4*)xrow + lane;
    f32x4 v[4]; float s = 0.f;
#pragma unroll
    for (int j = 0; j < 4; ++j) { v[j] = xr[64 * j]; s += (v[j].x * v[j].x + v[j].y * v[j].y) + (v[j].z * v[j].z + v[j].w * v[j].w); }
    const float r = __builtin_amdgcn_rsqf(wave_sum(s) * (1.f / DM) + EPS);
    unsigned long long* o8 = (unsigned long long*)orow + lane;
#pragma unroll
    for (int j = 0; j < 4; ++j) o8[64 * j] = (unsigned long long)pk2(v[j].x * r, v[j].y * r) | ((unsigned long long)pk2(v[j].z * r, v[j].w * r) << 32);
}
DI void resid_row(const float* xrow, const float* yrow, const float* g, float coef, float* orow, bf16* xnrow, int lane) {
    const f32x4* xr = (const f32x4*)xrow + lane; const f32x4* yr = (const f32x4*)yrow + lane; const f32x4* gr = (const f32x4*)g + lane;
    f32x4 xv[4], yv[4]; float s = 0.f;
#pragma unroll
    for (int j = 0; j < 4; ++j) { xv[j] = xr[64 * j]; yv[j] = yr[64 * j]; s += (yv[j].x * yv[j].x + yv[j].y * yv[j].y) + (yv[j].z * yv[j].z + yv[j].w * yv[j].w); }
    const float ry = __builtin_amdgcn_rsqf(wave_sum(s) * (1.f / DM) + EPS) * coef;
    float s2 = 0.f;
#pragma unroll
    for (int j = 0; j < 4; ++j) { const f32x4 gv = gr[64 * j]; xv[j] = xv[j] + (yv[j] * ry) * gv; s2 += (xv[j].x * xv[j].x + xv[j].y * xv[j].y) + (xv[j].z * xv[j].z + xv[j].w * xv[j].w); }
    f32x4* orp = (f32x4*)orow + lane;
#pragma unroll
    for (int j = 0; j < 4; ++j) orp[64 * j] = xv[j];
    if (xnrow) {
        const float r = __builtin_amdgcn_rsqf(wave_sum(s2) * (1.f / DM) + EPS);
        unsigned long long* o8 = (unsigned long long*)xnrow + lane;
#pragma unroll
        for (int j = 0; j < 4; ++j) o8[64 * j] = (unsigned long long)pk2(xv[j].x * r, xv[j].y * r) | ((unsigned long long)pk2(xv[j].z * r, xv[j].w * r) << 32);
    }
}

#define MFMA16(a, b, c) __builtin_amdgcn_mfma_f32_16x16x32_bf16((a), (b), (c), 0, 0, 0)

constexpr int AT_KS = 0, AT_KS_ROW = 144, AT_VT = 36864, AT_VT_ROW = 528, AT_PS = AT_VT + 64 * 528, AT_PS_WAVE = 16 * 528;
static_assert(AT_PS + 8 * AT_PS_WAVE <= LDS_BYTES, "attention LDS");
DI void attn_prompt_unit(LAS unsigned char* lds, const bf16* P, bf16* CAT, const float* sinks, int b, int nbk, int kvh, int tid, int lane, int wave) {
    {
        const int kj = tid >> 1, half = tid & 1; const int t = 128 * (nbk - 1) + kj;
        LAS unsigned char* krow = lds + AT_KS + kj * AT_KS_ROW + half * 64;
        LAS bf16* vt = (LAS bf16*)(lds + AT_VT);
        if (t < 0) {
            const v4u z = (v4u){0u, 0u, 0u, 0u};
#pragma unroll
            for (int c = 0; c < 4; ++c) *(LAS v4u*)(krow + 16 * c) = z;
#pragma unroll
            for (int i = 0; i < 32; ++i) vt[(32 * half + i) * (AT_VT_ROW / 2) + kj] = 0;
        } else {
            const bf16* prow = P + (size_t)(b * SEQ + t) * NIN;
            const v4u* kp = (const v4u*)(prow + C_K + 64 * kvh + 32 * half);
            v4u c0 = kp[0], c1 = kp[1], c2 = kp[2], c3 = kp[3];
            if (half == 0) {
                float x1[8], x2[8], o1[8], o2[8]; unpack8(c0, x1); unpack8(c1, x2);
#pragma unroll
                for (int i = 0; i < 8; ++i) { float c, s; rope_cs((float)t, i, c, s); o1[i] = x1[i] * c - x2[i] * s; o2[i] = x2[i] * c + x1[i] * s; }
                c0 = pack8(o1); c1 = pack8(o2);
            }
            *(LAS v4u*)(krow) = c0; *(LAS v4u*)(krow + 16) = c1; *(LAS v4u*)(krow + 32) = c2; *(LAS v4u*)(krow + 48) = c3;
            const v4u* vp = (const v4u*)(prow + C_V + 64 * kvh + 32 * half);
#pragma unroll
            for (int c = 0; c < 4; ++c) { const v4u raw = vp[c];
#pragma unroll
                for (int i = 0; i < 4; ++i) { vt[(32 * half + 8 * c + 2 * i) * (AT_VT_ROW / 2) + kj] = (bf16)(raw[i] & 0xffffu); vt[(32 * half + 8 * c + 2 * i + 1) * (AT_VT_ROW / 2) + kj] = (bf16)(raw[i] >> 16); } }
        }
    }
    __syncthreads();
    const int g = wave >> 1, qhalf = wave & 1, h = 4 * kvh + g, fr = lane & 15, fq = lane >> 4;
    const float sink2 = sinks[h] * LOG2E;
    LAS unsigned char* ps = lds + AT_PS + wave * AT_PS_WAVE;
#pragma unroll 1
    for (int sb = 0; sb < 4; ++sb) {
        const int q0 = 64 * qhalf + 16 * sb;
        bf16x8 qa[2];
        {
            const int qi = q0 + fr; const int t = 128 * nbk + qi;
            const bf16* qp = P + (size_t)(b * SEQ + t) * NIN + C_Q + 64 * h;
            v4u r0 = *(const v4u*)(qp + 8 * fq), r1 = *(const v4u*)(qp + 32 + 8 * fq);
            if (fq < 2) {
                const v4u other = *(const v4u*)(qp + 8 * (fq ^ 1));
                float a[8], o[8], x[8]; unpack8(r0, a); unpack8(other, o);
#pragma unroll
                for (int i = 0; i < 8; ++i) { float c, s; rope_cs((float)t, i, c, s); x[i] = fq == 0 ? a[i] * c - o[i] * s : a[i] * c + o[i] * s; }
                r0 = pack8(x);
            }
            qa[0] = __builtin_bit_cast(bf16x8, r0); qa[1] = __builtin_bit_cast(bf16x8, r1);
        }
        f32x4 sc[16];
#pragma unroll
        for (int n = 0; n < 16; ++n) {
            sc[n] = (f32x4){0.f, 0.f, 0.f, 0.f};
#pragma unroll
            for (int ks = 0; ks < 2; ++ks) { const bf16x8 kb = *(const LAS bf16x8*)(lds + AT_KS + (16 * n + fr) * AT_KS_ROW + (32 * ks + 8 * fq) * 2); sc[n] = MFMA16(qa[ks], kb, sc[n]); }
        }
        float mx[4], sm[4];
#pragma unroll
        for (int j = 0; j < 4; ++j) {
            const int qi = q0 + 4 * fq + j; float m = -1e30f;
#pragma unroll
            for (int n = 0; n < 16; ++n) { const int kj = 16 * n + fr; const bool valid = (kj > qi) && (kj <= qi + 128) && (nbk > 0 || kj >= 128);
                const float v = valid ? sc[n][j] * (0.125f * LOG2E) : -1e30f; sc[n][j] = v; m = fmaxf(m, v); }
            m = fmaxf(m, __shfl_xor(m, 1)); m = fmaxf(m, __shfl_xor(m, 2)); m = fmaxf(m, __shfl_xor(m, 4)); m = fmaxf(m, __shfl_xor(m, 8));
            m = fmaxf(m, sink2); mx[j] = m;
            float s = 0.f;
#pragma unroll
            for (int n = 0; n < 16; ++n) { const float p = __builtin_amdgcn_exp2f(sc[n][j] - m); sc[n][j] = p; s += p; }
            s += __shfl_xor(s, 1); s += __shfl_xor(s, 2); s += __shfl_xor(s, 4); s += __shfl_xor(s, 8);
            sm[j] = __builtin_amdgcn_rcpf(s + __builtin_amdgcn_exp2f(sink2 - m));
        }
#pragma unroll
        for (int n = 0; n < 16; ++n)
#pragma unroll
            for (int j = 0; j < 4; ++j) *(LAS bf16*)(ps + (4 * fq + j) * AT_VT_ROW + (16 * n + fr) * 2) = (bf16)f2bf(sc[n][j]);
        LDS_WAIT(); asm volatile("" ::: "memory");
        f32x4 o[4];
#pragma unroll
        for (int n = 0; n < 4; ++n) o[n] = (f32x4){0.f, 0.f, 0.f, 0.f};
#pragma unroll
        for (int ks = 0; ks < 8; ++ks) { const bf16x8 pa = *(const LAS bf16x8*)(ps + fr * AT_VT_ROW + (32 * ks + 8 * fq) * 2);
#pragma unroll
            for (int n = 0; n < 4; ++n) { const bf16x8 vb = *(const LAS bf16x8*)(lds + AT_VT + (16 * n + fr) * AT_VT_ROW + (32 * ks + 8 * fq) * 2); o[n] = MFMA16(pa, vb, o[n]); } }
        LDS_WAIT(); asm volatile("" ::: "memory");
#pragma unroll
        for (int j = 0; j < 4; ++j) { bf16* op = CAT + (size_t)(b * SEQ + 128 * nbk + q0 + 4 * fq + j) * DM + 64 * h + fr;
#pragma unroll
            for (int n = 0; n < 4; ++n) op[16 * n] = (bf16)f2bf(o[n][j] * sm[j]); }
    }
    __syncthreads();
}

constexpr int HG_ROW = 144, HG_QE = 0, HG_KE = 9216, HG_KD = 18432, HG_VT = 27648, HG_SP = 36864, HG_AM = 46080, HG_TOT = 55296;
template <int MODE> DI void hgrn_unit(LAS unsigned char* lds, const bf16* P, const float* lbv, float* Uws, float* Dws, const float* outg, bf16* CAT, int b, int h, int c, int tid, int lane, int wave) {
    const int r0 = b * SEQ + 64 * c; const int unit = (b * 8 + h) * 64 + c;
    const int fr = lane & 15, fq = lane >> 4;
    const float lb = lbv[64 * h + lane];
    float fv[8], gv[8], qv[8], vv[8];
    {
        float run = 0.f;
#pragma unroll
        for (int i = 0; i < 8; ++i) { const bf16* prow = P + (size_t)(r0 + 8 * wave + i) * NIN + 64 * h + lane;
            const float hf = bf2f(prow[C_HF]); vv[i] = bf2f(prow[C_HI]); if (MODE == 1) qv[i] = bf2f(prow[C_HQ]) * 0.125f;
            const float f = lb + (1.0f - lb) * sigmoid_f(hf); fv[i] = f; run += __logf(f); gv[i] = run; }
        ((LAS float*)(lds + HG_TOT))[wave * 64 + lane] = run;
    }
    __syncthreads();
    float pre = 0.f, GC = 0.f;
#pragma unroll
    for (int w = 0; w < 8; ++w) { const float t = ((LAS float*)(lds + HG_TOT))[w * 64 + lane]; GC += t; if (w < wave) pre += t; }
    {
        float vpk[8];
#pragma unroll
        for (int i = 0; i < 8; ++i) vpk[i] = vv[i];
        *(LAS v4u*)(lds + HG_VT + lane * HG_ROW + 16 * wave) = pack8(vpk);
        if (MODE == 0) {
            float kd[8];
#pragma unroll
            for (int i = 0; i < 8; ++i) kd[i] = (1.0f - fv[i]) * __expf(GC - (pre + gv[i]));
            *(LAS v4u*)(lds + HG_KD + lane * HG_ROW + 16 * wave) = pack8(kd);
            if (wave == 0) Dws[(size_t)unit * 64 + lane] = __expf(GC);
        } else {
#pragma unroll
            for (int i = 0; i < 8; ++i) { const float G = pre + gv[i]; const int t = 8 * wave + i;
                *(LAS bf16*)(lds + HG_QE + t * HG_ROW + lane * 2) = (bf16)f2bf(qv[i] * __expf(G));
                *(LAS bf16*)(lds + HG_KE + t * HG_ROW + lane * 2) = (bf16)f2bf((1.0f - fv[i]) * __expf(-G)); }
            float sp[8];
#pragma unroll
            for (int i = 0; i < 8; ++i) sp[i] = Uws[(size_t)unit * 4096 + (8 * wave + i) * 64 + lane];
            *(LAS v4u*)(lds + HG_SP + lane * HG_ROW + 16 * wave) = pack8(sp);
        }
    }
    __syncthreads();
    if (MODE == 0) {
        const int mb = wave >> 1;
#pragma unroll
        for (int nn = 0; nn < 2; ++nn) { const int nb = 2 * (wave & 1) + nn; f32x4 acc = (f32x4){0.f, 0.f, 0.f, 0.f};
#pragma unroll
            for (int ks = 0; ks < 2; ++ks) { const bf16x8 a = *(const LAS bf16x8*)(lds + HG_KD + (16 * mb + fr) * HG_ROW + (32 * ks + 8 * fq) * 2);
                const bf16x8 bb = *(const LAS bf16x8*)(lds + HG_VT + (16 * nb + fr) * HG_ROW + (32 * ks + 8 * fq) * 2); acc = MFMA16(a, bb, acc); }
#pragma unroll
            for (int j = 0; j < 4; ++j) Uws[(size_t)unit * 4096 + (16 * mb + 4 * fq + j) * 64 + 16 * nb + fr] = acc[j]; }
    } else {
        {
            const int mb = wave >> 1;
#pragma unroll
            for (int nn = 0; nn < 2; ++nn) { const int nb = 2 * (wave & 1) + nn; f32x4 acc = (f32x4){0.f, 0.f, 0.f, 0.f};
#pragma unroll
                for (int ks = 0; ks < 2; ++ks) { const bf16x8 a = *(const LAS bf16x8*)(lds + HG_QE + (16 * mb + fr) * HG_ROW + (32 * ks + 8 * fq) * 2);
                    const bf16x8 bb = *(const LAS bf16x8*)(lds + HG_KE + (16 * nb + fr) * HG_ROW + (32 * ks + 8 * fq) * 2); acc = MFMA16(a, bb, acc); }
#pragma unroll
                for (int j = 0; j < 4; ++j) { const int t = 16 * mb + 4 * fq + j, s = 16 * nb + fr;
                    *(LAS bf16*)(lds + HG_AM + t * HG_ROW + s * 2) = (bf16)f2bf(s <= t ? acc[j] : 0.f); } }
        }
        __syncthreads();
        if (wave < 4) {
            const int mb = wave; f32x4 o[4];
#pragma unroll
            for (int n = 0; n < 4; ++n) o[n] = (f32x4){0.f, 0.f, 0.f, 0.f};
#pragma unroll
            for (int ks = 0; ks < 2; ++ks) {
                const bf16x8 aq = *(const LAS bf16x8*)(lds + HG_QE + (16 * mb + fr) * HG_ROW + (32 * ks + 8 * fq) * 2);
                const bf16x8 am = *(const LAS bf16x8*)(lds + HG_AM + (16 * mb + fr) * HG_ROW + (32 * ks + 8 * fq) * 2);
#pragma unroll
                for (int n = 0; n < 4; ++n) {
                    const bf16x8 bs = *(const LAS bf16x8*)(lds + HG_SP + (16 * n + fr) * HG_ROW + (32 * ks + 8 * fq) * 2);
                    const bf16x8 bv = *(const LAS bf16x8*)(lds + HG_VT + (16 * n + fr) * HG_ROW + (32 * ks + 8 * fq) * 2);
                    o[n] = MFMA16(aq, bs, o[n]); o[n] = MFMA16(am, bv, o[n]); }
            }
#pragma unroll
            for (int j = 0; j < 4; ++j) {
                float ss = 0.f;
#pragma unroll
                for (int n = 0; n < 4; ++n) ss += o[n][j] * o[n][j];
                ss += __shfl_xor(ss, 1); ss += __shfl_xor(ss, 2); ss += __shfl_xor(ss, 4); ss += __shfl_xor(ss, 8);
                const float r = __builtin_amdgcn_rsqf(ss * (1.0f / 64.0f) + EPS);
                const int t = 16 * mb + 4 * fq + j;
                const bf16* gp = P + (size_t)(r0 + t) * NIN + C_HG + 64 * h + fr;
                bf16* op = CAT + (size_t)(r0 + t) * DM + 512 + 64 * h + fr;
#pragma unroll
                for (int n = 0; n < 4; ++n) op[16 * n] = (bf16)f2bf(o[n][j] * r * outg[16 * n + fr] * silu2_f(bf2f(gp[16 * n])));
            }
        }
    }
    __syncthreads();
}

constexpr int SA_KL = 0, SA_VL = 33280, SA_QL = 66048, SA_SL = 67072, SA_RL = 69120;
DI void attn_sample_unit(LAS unsigned char* lds, const bf16* P, const float* cache_k, const float* cache_v, const float* sinks, float* out, bf16* CAT, int b, int kvh, int tid, int lane, int wave) {
    LAS float* KL = (LAS float*)(lds + SA_KL); LAS float* VL = (LAS float*)(lds + SA_VL); LAS float* QL = (LAS float*)(lds + SA_QL); LAS float* SL = (LAS float*)(lds + SA_SL); LAS float* RL = (LAS float*)(lds + SA_RL);
    const bf16* prow = P + (size_t)(MPROMPT + b) * NIN;
#pragma unroll 4
    for (int i = 0; i < 16; ++i) { const int idx = tid + 512 * i, key = idx >> 6, d = idx & 63; float kv, vv;
        if (key < 127) { const size_t src = ((size_t)(b * 128 + key + 1) * 2 + kvh) * 64 + d; kv = cache_k[src]; vv = cache_v[src]; }
        else { const bf16* hp = prow + C_K + 64 * kvh; kv = d < 16 ? rope_elem(hp, d, PAST_POS) : bf2f(hp[d]); vv = bf2f(prow[C_V + 64 * kvh + d]); }
        KL[key * 65 + d] = kv; VL[key * 64 + d] = vv;
        const size_t dst = ((size_t)(b * 128 + key) * 2 + kvh) * 64 + d; out[O_WKS + dst] = kv; out[O_WVS + dst] = vv; }
    if (tid < 256) { const int g = tid >> 6, d = tid & 63; const bf16* hp = prow + C_Q + 64 * (4 * kvh + g);
        const float q = d < 16 ? rope_elem(hp, d, PAST_POS) : bf2f(hp[d]); QL[g * 64 + d] = q * (0.125f * LOG2E); }
    __syncthreads();
    { const int g = tid >> 7, j = tid & 127; float s = 0.f;
#pragma unroll 16
      for (int d = 0; d < 64; ++d) s += QL[g * 64 + d] * KL[j * 65 + d];
      SL[g * 128 + j] = s; }
    __syncthreads();
    if (wave < 4) { const int g = wave; const float sink2 = sinks[4 * kvh + g] * LOG2E; const float s0 = SL[g * 128 + lane], s1 = SL[g * 128 + 64 + lane];
        const float m = fmaxf(wave_max(fmaxf(s0, s1)), sink2); const float p0 = __builtin_amdgcn_exp2f(s0 - m), p1 = __builtin_amdgcn_exp2f(s1 - m);
        const float sum = wave_sum(p0 + p1) + __builtin_amdgcn_exp2f(sink2 - m); SL[g * 128 + lane] = p0; SL[g * 128 + 64 + lane] = p1; if (lane == 0) RL[g] = 1.0f / sum; }
    __syncthreads();
    if (tid < 256) { const int g = tid >> 6, d = tid & 63; float o = 0.f;
#pragma unroll 16
        for (int j = 0; j < 128; ++j) o += SL[g * 128 + j] * VL[j * 64 + d];
        CAT[(size_t)(MPROMPT + b) * DM + 64 * (4 * kvh + g) + d] = (bf16)f2bf(o * RL[g]); }
    __syncthreads();
}
DI void hgrn_sample_unit(const bf16* P, const float* lbv, const float* state, const float* outg, float* out, bf16* CAT, int b, int h, int lane) {
    const bf16* prow = P + (size_t)(MPROMPT + b) * NIN + 64 * h + lane;
    const float lb = lbv[64 * h + lane];
    const float q = bf2f(prow[C_HQ]) * 0.125f, f = lb + (1.0f - lb) * sigmoid_f(bf2f(prow[C_HF])), kk = 1.0f - f, v = bf2f(prow[C_HI]), hg = bf2f(prow[C_HG]);
    const float* S = state + (size_t)(b * 8 + h) * 4096 + lane; float* So = out + O_SS + (size_t)(b * 8 + h) * 4096 + lane;
    float o = 0.f;
#pragma unroll 8
    for (int k = 0; k < 64; ++k) { const float fk = __shfl(f, k), kkk = __shfl(kk, k), qk = __shfl(q, k); const float sn = fk * S[k * 64] + kkk * v; So[k * 64] = sn; o += qk * sn; }
    const float r = __builtin_amdgcn_rsqf(wave_sum(o * o) * (1.0f / 64.0f) + EPS);
    CAT[(size_t)(MPROMPT + b) * DM + 512 + 64 * h + lane] = (bf16)f2bf(o * r * outg[lane] * silu2_f(hg));
}

struct Args { const float* in[20]; float* out; unsigned char* ws; };
__global__ void __launch_bounds__(512, 2) mk_fwd(Args args) {
    extern __shared__ __attribute__((aligned(16))) unsigned char lds_raw[];
    cg::grid_group grid = cg::this_grid();
    LAS unsigned char* lds = (LAS unsigned char*)lds_raw;
    const int tid = threadIdx.x, lane = tid & 63, wave = __builtin_amdgcn_readfirstlane(tid >> 6);
    const int G = gridDim.x, bid = blockIdx.x, gw = bid * 8 + wave, NGW = G * 8;
    unsigned char* ws = args.ws; float* out = args.out;
    const float* x_prompt = args.in[0]; const float* x_sample = args.in[1];
    bf16* Wgu1 = (bf16*)(ws + WS_WGU1); bf16* Wdn1 = (bf16*)(ws + WS_WDN1); bf16* Win = (bf16*)(ws + WS_WIN); bf16* Wout = (bf16*)(ws + WS_WOUT);
    bf16* Wgu2 = (bf16*)(ws + WS_WGU2); bf16* Wdn2 = (bf16*)(ws + WS_WDN2);
    float* LBV = (float*)(ws + WS_LB); bf16* XN = (bf16*)(ws + WS_XN); bf16* ACT = (bf16*)(ws + WS_ACT); float* Y = (float*)(ws + WS_Y);
    float* Uws = (float*)(ws + WS_U); float* Dws = (float*)(ws + WS_D);

    {
        LAS float* scr = (LAS float*)(lds + wave * 16384);
        constexpr int I_GU = 16 * 176, I_DN = 44 * 32, I_IN = 16 * 88, I_OUT = 16 * 32, NITEMS = 2 * I_GU + 2 * I_DN + I_IN + I_OUT;
        for (int it = gw; it < NITEMS; it += NGW) {
            int r = it;
            if (r < I_GU) { tr_item<1>(args.in[7], DM, NGU, args.in[5], Wgu1, scr, r, lane); continue; } r -= I_GU;
            if (r < I_GU) { tr_item<1>(args.in[18], DM, NGU, args.in[16], Wgu2, scr, r, lane); continue; } r -= I_GU;
            if (r < I_DN) { tr_item<0>(args.in[8], DFF, DM, nullptr, Wdn1, scr, r, lane); continue; } r -= I_DN;
            if (r < I_DN) { tr_item<0>(args.in[19], DFF, DM, nullptr, Wdn2, scr, r, lane); continue; } r -= I_DN;
            if (r < I_IN) { tr_item<0>(args.in[11], DM, NIN, args.in[9], Win, scr, r, lane); continue; } r -= I_IN;
            tr_item<0>(args.in[15], DM, DM, nullptr, Wout, scr, r, lane);
        }
        for (int m = gw; m < MPAD; m += NGW) {
            if (m < MTOK) norm_row_to_bf16(m < MPROMPT ? x_prompt + (size_t)m * DM : x_sample + (size_t)(m - MPROMPT) * DM, XN + (size_t)m * DM, lane);
            else { unsigned long long* o8 = (unsigned long long*)(XN + (size_t)m * DM) + lane;
#pragma unroll
                for (int j = 0; j < 4; ++j) o8[64 * j] = 0ull; }
        }
        if (bid == 0) { const float* l = args.in[13]; LBV[tid] = 1.0f / (1.0f + __expf(l[512 + tid] - l[tid])); }
    }
    grid.sync();
    { pg8::Gemm g{XN, Wgu1, MPAD, NGU, DM}; pg8::StaticOrder S; S.init(MPAD, NGU, G, bid); pg8::EpiSwiGLU E{ACT, DFF};
      pg8::gemm_phase<pg8::EpiSwiGLU, pg8::StaticOrder, true, true>(lds, g, S, E); }
    grid.sync();
    { pg8::Gemm g{ACT, Wdn1, MPAD, DM, DFF}; pg8::StaticOrder S; S.init(MPAD, DM, G, bid); pg8::EpiF32 E{Y, DM};
      pg8::gemm_phase<pg8::EpiF32, pg8::StaticOrder, true, true>(lds, g, S, E); }
    grid.sync();
    for (int m = gw; m < MTOK; m += NGW)
        resid_row(m < MPROMPT ? x_prompt + (size_t)m * DM : x_sample + (size_t)(m - MPROMPT) * DM, Y + (size_t)m * DM, args.in[6], 0.5f, out + (size_t)m * DM, XN + (size_t)m * DM, lane);
    grid.sync();
    { pg8::Gemm g{XN, Win, MPAD, NIN, DM}; pg8::StaticOrder S; S.init(MPAD, NIN, G, bid); pg8::EpiBf16 E{ACT, NIN};
      pg8::gemm_phase<pg8::EpiBf16, pg8::StaticOrder, true, true>(lds, g, S, E); }
    grid.sync();
    {
        const bf16* P = ACT; bf16* CAT = XN;
        for (int u = bid; u < 256; u += G) attn_prompt_unit(lds, P, CAT, args.in[12], u >> 6, (u >> 1) & 31, u & 1, tid, lane, wave);
        for (int u = bid; u < 2048; u += G) hgrn_unit<0>(lds, P, LBV, Uws, Dws, args.in[14], CAT, u >> 9, (u >> 6) & 7, u & 63, tid, lane, wave);
        for (int u = bid; u < 256; u += G) attn_sample_unit(lds, P, args.in[2], args.in[3], args.in[12], out, CAT, u >> 1, u & 1, tid, lane, wave);
        for (int u = gw; u < 1024; u += NGW) hgrn_sample_unit(P, LBV, args.in[4], args.in[14], out, CAT, u >> 3, u & 7, lane);
        for (int e = bid * 512 + tid; e < 131072; e += G * 512) {
            const int which = e >> 16, r = e & 65535, b = r >> 14, j = (r >> 7) & 127, kvh = (r >> 6) & 1, d = r & 63;
            const bf16* prow = P + (size_t)(b * SEQ + SEQ - 128 + j) * NIN;
            float v;
            if (which == 0) { const bf16* hp = prow + C_K + 64 * kvh; v = d < 16 ? rope_elem(hp, d, (float)(SEQ - 128 + j)) : bf2f(hp[d]); }
            else v = bf2f(prow[C_V + 64 * kvh + d]);
            out[O_WKP + e] = v;
        }
    }
    grid.sync();
    for (int e = bid * 512 + tid; e < 32 * 4096; e += G * 512) {
        const int bh = e >> 12, kd = e & 4095, k = kd >> 6; float S = 0.f;
        float* up = Uws + (size_t)bh * 64 * 4096 + kd; const float* dp = Dws + (size_t)bh * 64 * 64 + k;
#pragma unroll 8
        for (int c = 0; c < 64; ++c) { const float U = up[(size_t)c * 4096], D = dp[c * 64]; up[(size_t)c * 4096] = S; S = D * S + U; }
        out[O_SP + e] = S;
    }
    grid.sync();
    {
        const bf16* P = ACT; bf16* CAT = XN;
        for (int u = bid; u < 2048; u += G) hgrn_unit<1>(lds, P, LBV, Uws, Dws, args.in[14], CAT, u >> 9, (u >> 6) & 7, u & 63, tid, lane, wave);
    }
    grid.sync();
    { pg8::Gemm g{XN, Wout, MPAD, DM, DM}; pg8::StaticOrder S; S.init(MPAD, DM, G, bid); pg8::EpiF32 E{Y, DM};
      pg8::gemm_phase<pg8::EpiF32, pg8::StaticOrder, true, true>(lds, g, S, E); }
    grid.sync();
    for (int m = gw; m < MTOK; m += NGW) resid_row(out + (size_t)m * DM, Y + (size_t)m * DM, args.in[10], 1.0f, out + (size_t)m * DM, XN + (size_t)m * DM, lane);
    grid.sync();
    { pg8::Gemm g{XN, Wgu2, MPAD, NGU, DM}; pg8::StaticOrder S; S.init(MPAD, NGU, G, bid); pg8::EpiSwiGLU E{ACT, DFF};
      pg8::gemm_phase<pg8::EpiSwiGLU, pg8::StaticOrder, true, true>(lds, g, S, E); }
    grid.sync();
    { pg8::Gemm g{ACT, Wdn2, MPAD, DM, DFF}; pg8::StaticOrder S; S.init(MPAD, DM, G, bid); pg8::EpiF32 E{Y, DM};
      pg8::gemm_phase<pg8::EpiF32, pg8::StaticOrder, true, true>(lds, g, S, E); }
    grid.sync();
    for (int m = gw; m < MTOK; m += NGW) resid_row(out + (size_t)m * DM, Y + (size_t)m * DM, args.in[17], 0.5f, out + (size_t)m * DM, nullptr, lane);
}

extern "C" void kernel_launch(void* const* d_in, const int* in_sizes, int n_in, void* d_out, int out_size, void* d_ws, size_t ws_size, hipStream_t stream) {
    static int grid = 0;
    if (grid == 0) {
        int dev = 0, cus = 0, per_cu = 0;
        (void)hipGetDevice(&dev);
        (void)hipDeviceGetAttribute(&cus, hipDeviceAttributeMultiprocessorCount, dev);
        (void)hipFuncSetAttribute((const void*)mk_fwd, hipFuncAttributeMaxDynamicSharedMemorySize, LDS_BYTES);
        if (hipOccupancyMaxActiveBlocksPerMultiprocessor(&per_cu, (const void*)mk_fwd, 512, LDS_BYTES) != hipSuccess || per_cu < 1) { fprintf(stderr, "occupancy query: %d blocks per CU\n", per_cu); per_cu = 1; }
        (void)hipGetLastError();
        grid = cus * (per_cu > 1 ? 1 : per_cu);
        if (n_in != 20 || ws_size < WS_END) { fprintf(stderr, "kernel_launch: unexpected inputs (n_in %d, ws %zu)\n", n_in, ws_size); grid = -1; }
    }
    if (grid < 0) return;
    Args a{};
    for (int i = 0; i < 20; ++i) a.in[i] = (const float*)d_in[i];
    a.out = (float*)d_out; a.ws = (unsigned char*)d_ws;
    void* kargs[] = {&a};
    hipError_t e = hipLaunchCooperativeKernel((const void*)mk_fwd, dim3(grid), dim3(512), kargs, LDS_BYTES, stream);
    if (e != hipSuccess) fprintf(stderr, "cooperative launch failed: %s (grid %d)\n", hipGetErrorString(e), grid);
}
```

```cpp
#include <hip/hip_runtime.h>
#include <hip/hip_cooperative_groups.h>
#include <cstdio>
#include <cstdint>
namespace cg = cooperative_groups;
#ifndef REP_P0
#define REP_P0 1
#endif
#ifndef REP_MIX
#define REP_MIX 1
#endif
#ifndef REP_P3
#define REP_P3 1
#endif
namespace pg8 {
#define PG8_LAS __attribute__((address_space(3)))
typedef unsigned short bf16_t;
typedef short bf16x8 __attribute__((ext_vector_type(8)));
typedef float f32x4 __attribute__((ext_vector_type(4)));
typedef unsigned u32x4 __attribute__((ext_vector_type(4)));
constexpr int BM = 256, BK = 64, HALF = 128, HTB = HALF * BK * 2  , STAGE_BYTES = 8 * HTB, NXCD = 8, WGM = 8;

__host__ __device__ __forceinline__ int lds_byte(int r, int c) { const int st = (r >> 4) * 2 + (c >> 5), rr = r & 15, cc = c & 31, ob = rr * 64 + cc * 2; return st * 1024 + (ob ^ (((ob >> 9) & 1) << 5)); }
__host__ __device__ __forceinline__ void stage_rc(int b, int& R, int& C) { const int st = b / 1024, sb = b % 1024, swz = sb ^ (((sb >> 9) & 1) << 5); R = (st >> 1) * 16 + swz / 64; C = (st & 1) * 32 + (swz % 64) / 2; }
__host__ __device__ __forceinline__ int perm32(int rho) { const int n = rho >> 4, i = rho & 15; return 8 * (i >> 2) + 4 * n + (i & 3); }

struct Unit { int pm, pn; };
struct Gemm { const bf16_t* A; const bf16_t* Bt; int M, N, K; };

struct StaticOrder {
    int nM, nN, nwg, G, c;
    __host__ __device__ void init(int M, int N, int G_, int c_) { nM = M / BM; nN = N / BM; nwg = nM * nN; G = G_; c = c_; }
    __host__ __device__ bool next(int i, Unit& u) const {
        const long L = (long)i * G + c; if (L >= nwg) return false;
        int wgid = (int)L; { const int q = nwg / NXCD, r = nwg % NXCD, xcd = wgid % NXCD, off = wgid / NXCD; wgid = (xcd < r ? xcd * (q + 1) : r * (q + 1) + (xcd - r) * q) + off; }
        const int nig = WGM * nN, gid = wgid / nig, fm = gid * WGM, gsz = (nM - fm) < WGM ? (nM - fm) : WGM;
        u.pm = fm + ((wgid % nig) % gsz); u.pn = (wgid % nig) / gsz; return true;
    }
    __device__ __forceinline__ void a_ready(const Unit&) const {}
    __device__ __forceinline__ void done(const Unit&) const {}
};

__device__ __forceinline__ unsigned cvt_pk_bf16(float lo, float hi) { unsigned r; asm volatile("v_cvt_pk_bf16_f32 %0, %1, %2" : "=v"(r) : "v"(lo), "v"(hi)); return r; }
typedef float f32x2 __attribute__((ext_vector_type(2)));
struct EpiBf16 {
    static constexpr bool PERM = true, AFTER_DRAIN = false;
    bf16_t* O; int ldc;
    __device__ __forceinline__ void operator()(const f32x4 (&acc)[2][2][4][2], const Unit& u, int wr, int wc, int fr, int fq) const {
        const int row0 = u.pm * BM + wr * 64 + fr; const int col0 = u.pn * BM + wc * 32 + 8 * fq;
#pragma unroll
        for (int ai = 0; ai < 2; ++ai)
#pragma unroll
            for (int m = 0; m < 4; ++m) { bf16_t* rowp = O + (size_t)(row0 + ai * HALF + m * 16) * ldc + col0;
#pragma unroll
                for (int bj = 0; bj < 2; ++bj) { const f32x4 v0 = acc[ai][bj][m][0], v1 = acc[ai][bj][m][1];
                    u32x4 w; w.x = cvt_pk_bf16(v0[0], v0[1]); w.y = cvt_pk_bf16(v0[2], v0[3]); w.z = cvt_pk_bf16(v1[0], v1[1]); w.w = cvt_pk_bf16(v1[2], v1[3]);
                    *(u32x4*)(rowp + bj * HALF) = w; } }
    }
};
__device__ __forceinline__ float silu_f(float g) { return g * __builtin_amdgcn_rcpf(1.0f + __expf(-g)); }
struct EpiSwiGLU {
    static constexpr bool PERM = true, AFTER_DRAIN = false;
    bf16_t* O; int ldc;
    __device__ __forceinline__ void operator()(const f32x4 (&acc)[2][2][4][2], const Unit& u, int wr, int wc, int fr, int fq) const {
        const int row0 = u.pm * BM + wr * 64 + fr; const int col0 = u.pn * HALF + wc * 32 + 8 * fq;
#pragma unroll
        for (int ai = 0; ai < 2; ++ai)
#pragma unroll
            for (int m = 0; m < 4; ++m) { bf16_t* rowp = O + (size_t)(row0 + ai * HALF + m * 16) * ldc + col0;
                const f32x4 g0 = acc[ai][0][m][0], g1 = acc[ai][0][m][1], u0 = acc[ai][1][m][0], u1 = acc[ai][1][m][1];
                u32x4 w;
                w.x = cvt_pk_bf16(silu_f(g0[0]) * u0[0], silu_f(g0[1]) * u0[1]); w.y = cvt_pk_bf16(silu_f(g0[2]) * u0[2], silu_f(g0[3]) * u0[3]);
                w.z = cvt_pk_bf16(silu_f(g1[0]) * u1[0], silu_f(g1[1]) * u1[1]); w.w = cvt_pk_bf16(silu_f(g1[2]) * u1[2], silu_f(g1[3]) * u1[3]);
                *(u32x4*)rowp = w; }
    }
};
struct EpiF32 {
    static constexpr bool PERM = false, AFTER_DRAIN = false;
    float* O; int ldc;
    __device__ __forceinline__ void operator()(const f32x4 (&acc)[2][2][4][2], const Unit& u, int wr, int wc, int fr, int fq) const {
        const int row0 = u.pm * BM + wr * 64 + fr; const int col0 = u.pn * BM + wc * 32 + 4 * fq;
#pragma unroll
        for (int ai = 0; ai < 2; ++ai)
#pragma unroll
            for (int m = 0; m < 4; ++m) { float* rowp = O + (size_t)(row0 + ai * HALF + m * 16) * ldc + col0;
#pragma unroll
                for (int bj = 0; bj < 2; ++bj)
#pragma unroll
                    for (int n = 0; n < 2; ++n) *(f32x4*)(rowp + bj * HALF + n * 16) = acc[ai][bj][m][n]; }
    }
};
template <class Epi, class Sched, bool ALIGN_EPI = false, bool SP2 = false>
__device__ __forceinline__ void gemm_phase(PG8_LAS unsigned char* lds, const Gemm g, const Sched& S, const Epi& E) {
    const int tid = threadIdx.x, wid = __builtin_amdgcn_readfirstlane(tid >> 6), lane = tid & 63, wr = wid >> 2, wc = wid & 3, fr = lane & 15, fq = lane >> 4;
    const int K = g.K, nt = K / BK;
    unsigned voffA[2], voffB[2];
#pragma unroll
    for (int i = 0; i < 2; ++i) { int R, C; stage_rc(tid * 16 + i * 8192, R, C); const int Rb = Epi::PERM ? ((R & ~31) + perm32(R & 31)) : R;
        voffA[i] = (unsigned)(R * K + C) * 2u; voffB[i] = (unsigned)(Rb * K + C) * 2u; }
    const size_t kstep = (size_t)(BK * 2);
    const size_t hstep = (size_t)HALF * K * 2;
    const size_t tstep = 2 * hstep;
    const unsigned ldsw = (unsigned)wid * 1024u;
    const int aoff = lds_byte(wr * 64 + fr, fq * 8), boff = lds_byte(wc * 32 + fr, fq * 8);
#define PG8_SA(b, h) (((b) * 2 + (h)) * HTB)
#define PG8_SB(b, h) ((4 + (b) * 2 + (h)) * HTB)
#define PG8_STAGE(bufoff, gbase, voff) do { _Pragma("unroll") for (int _i = 0; _i < 2; ++_i) \
        __builtin_amdgcn_global_load_lds((const unsigned*)((const char*)(gbase) + (voff)[_i]), (PG8_LAS unsigned*)(lds + (bufoff) + ldsw + _i * 8192), 16, 0, 0); } while (0)
#define PG8_LDA(dst, b, h) do { _Pragma("unroll") for (int m = 0; m < 4; ++m) _Pragma("unroll") for (int k = 0; k < 2; ++k) dst[m][k] = *(const PG8_LAS bf16x8*)(lds + PG8_SA(b, h) + aoff + m * 2048 + k * 1024); } while (0)
#define PG8_LDB(dst, b, h) do { _Pragma("unroll") for (int n = 0; n < 2; ++n) _Pragma("unroll") for (int k = 0; k < 2; ++k) dst[n][k] = *(const PG8_LAS bf16x8*)(lds + PG8_SB(b, h) + boff + n * 2048 + k * 1024); } while (0)
#define PG8_MMA(ai, bj, At, Bt) do { __builtin_amdgcn_s_setprio(1); _Pragma("unroll") for (int m = 0; m < 4; ++m) _Pragma("unroll") for (int n = 0; n < 2; ++n) _Pragma("unroll") for (int k = 0; k < 2; ++k) \
        acc[ai][bj][m][n] = __builtin_amdgcn_mfma_f32_16x16x32_bf16(Bt[n][k], At[m][k], acc[ai][bj][m][n], 0, 0, 0); __builtin_amdgcn_s_setprio(0); } while (0)
#define PG8_WAIT_V(n) asm volatile("s_waitcnt vmcnt(" #n ")" ::: "memory")
#define PG8_WAIT_L(n) asm volatile("s_waitcnt lgkmcnt(" #n ")" ::: "memory")
#define PG8_BAR __builtin_amdgcn_s_barrier()
#define PG8_SCHED __builtin_amdgcn_sched_barrier(0)
    Unit cur, nxt; int ui = 0;
    if (!S.next(0, cur)) return;
    f32x4 acc[2][2][4][2];
#pragma unroll
    for (int a = 0; a < 2; ++a)
#pragma unroll
        for (int b = 0; b < 2; ++b)
#pragma unroll
            for (int m = 0; m < 4; ++m)
#pragma unroll
                for (int n = 0; n < 2; ++n) acc[a][b][m][n] = (f32x4){0.f, 0.f, 0.f, 0.f};
    bf16x8 At[4][2], B0[2][2], B1[2][2];
    const char* cA = (const char*)g.A + (size_t)cur.pm * tstep; const char* cB = (const char*)g.Bt + (size_t)cur.pn * tstep;
    S.a_ready(cur);
    if constexpr (SP2) {
        PG8_STAGE(PG8_SB(0, 0), cB, voffB); PG8_STAGE(PG8_SB(0, 1), cB + hstep, voffB); PG8_STAGE(PG8_SA(0, 0), cA, voffA); PG8_STAGE(PG8_SA(0, 1), cA + hstep, voffA);
        if (wr == 1) PG8_BAR;
        PG8_WAIT_V(2); PG8_BAR;
        PG8_STAGE(PG8_SB(1, 0), cB + kstep, voffB); PG8_STAGE(PG8_SA(1, 0), cA + kstep, voffA); PG8_STAGE(PG8_SB(1, 1), cB + hstep + kstep, voffB);
        PG8_WAIT_V(6); PG8_BAR;
    } else {
        PG8_STAGE(PG8_SB(0, 0), cB, voffB); PG8_STAGE(PG8_SA(0, 0), cA, voffA); PG8_STAGE(PG8_SB(0, 1), cB + hstep, voffB); PG8_STAGE(PG8_SA(0, 1), cA + hstep, voffA);
        if (wr == 1) PG8_BAR;
        PG8_WAIT_V(4); PG8_BAR;
        PG8_STAGE(PG8_SB(1, 0), cB + kstep, voffB); PG8_STAGE(PG8_SA(1, 0), cA + kstep, voffA); PG8_STAGE(PG8_SB(1, 1), cB + hstep + kstep, voffB);
        PG8_WAIT_V(6); PG8_BAR;
    }
    for (;;) {
        const bool has_next = S.next(ui + 1, nxt);
        const char* nA = has_next ? (const char*)g.A + (size_t)nxt.pm * tstep : cA; const char* nB = has_next ? (const char*)g.Bt + (size_t)nxt.pn * tstep : cB;
        for (int t = 0; t < nt; t += 2) {
            const bool last = (t == nt - 2);
            const char* a1 = cA + (size_t)(t + 1) * kstep;
            const char* a2 = last ? nA : cA + (size_t)(t + 2) * kstep; const char* b2 = last ? nB : cB + (size_t)(t + 2) * kstep;
            const char* a3 = a2 + kstep; const char* b3 = b2 + kstep;
            if (last && has_next) S.a_ready(nxt);
            if constexpr (SP2) {
            PG8_LDB(B0, 0, 0); PG8_LDB(B1, 0, 1); PG8_SCHED; PG8_LDA(At, 0, 0); PG8_STAGE(PG8_SA(1, 1), a1 + hstep, voffA);
            PG8_WAIT_V(8); PG8_WAIT_L(0); PG8_BAR; PG8_MMA(0, 0, At, B0); PG8_MMA(0, 1, At, B1); PG8_BAR; PG8_SCHED;
            PG8_LDA(At, 0, 1); PG8_STAGE(PG8_SB(0, 0), b2, voffB); PG8_STAGE(PG8_SB(0, 1), b2 + hstep, voffB); PG8_STAGE(PG8_SA(0, 0), a2, voffA);
            PG8_WAIT_V(8); PG8_WAIT_L(0); PG8_BAR; PG8_MMA(1, 0, At, B0); PG8_MMA(1, 1, At, B1); PG8_BAR; PG8_SCHED;
            PG8_LDB(B0, 1, 0); PG8_LDB(B1, 1, 1); PG8_SCHED; PG8_LDA(At, 1, 0); PG8_STAGE(PG8_SA(0, 1), a2 + hstep, voffA);
            PG8_WAIT_V(8); PG8_WAIT_L(0); PG8_BAR; PG8_MMA(0, 0, At, B0); PG8_MMA(0, 1, At, B1); PG8_BAR; PG8_SCHED;
            PG8_LDA(At, 1, 1); PG8_STAGE(PG8_SB(1, 0), b3, voffB); PG8_STAGE(PG8_SB(1, 1), b3 + hstep, voffB); PG8_STAGE(PG8_SA(1, 0), a3, voffA);
            PG8_WAIT_V(8); PG8_WAIT_L(0); PG8_BAR; PG8_MMA(1, 0, At, B0); PG8_MMA(1, 1, At, B1); PG8_BAR; PG8_SCHED;
            } else {
            PG8_LDB(B0, 0, 0); PG8_SCHED; PG8_LDA(At, 0, 0); PG8_STAGE(PG8_SA(1, 1), a1 + hstep, voffA);
            PG8_WAIT_L(8); PG8_BAR; PG8_WAIT_L(0); PG8_MMA(0, 0, At, B0); PG8_BAR; PG8_SCHED;
            PG8_LDB(B1, 0, 1); PG8_STAGE(PG8_SB(0, 0), b2, voffB);
            PG8_BAR; PG8_WAIT_L(0); PG8_MMA(0, 1, At, B1); PG8_BAR;
            PG8_LDA(At, 0, 1); PG8_STAGE(PG8_SA(0, 0), a2, voffA);
            PG8_BAR; PG8_WAIT_L(0); PG8_MMA(1, 0, At, B0); PG8_BAR; PG8_SCHED;
            PG8_STAGE(PG8_SB(0, 1), b2 + hstep, voffB);
            PG8_WAIT_V(6); PG8_BAR; PG8_MMA(1, 1, At, B1); PG8_BAR;
            PG8_LDB(B0, 1, 0); PG8_SCHED; PG8_LDA(At, 1, 0); PG8_STAGE(PG8_SA(0, 1), a2 + hstep, voffA);
            PG8_WAIT_L(8); PG8_BAR; PG8_WAIT_L(0); PG8_MMA(0, 0, At, B0); PG8_BAR; PG8_SCHED;
            PG8_LDB(B1, 1, 1); PG8_STAGE(PG8_SB(1, 0), b3, voffB);
            PG8_BAR; PG8_WAIT_L(0); PG8_MMA(0, 1, At, B1); PG8_BAR;
            PG8_LDA(At, 1, 1); PG8_STAGE(PG8_SA(1, 0), a3, voffA);
            PG8_BAR; PG8_WAIT_L(0); PG8_MMA(1, 0, At, B0); PG8_BAR; PG8_SCHED;
            PG8_STAGE(PG8_SB(1, 1), b3 + hstep, voffB);
            PG8_WAIT_V(6); PG8_BAR; PG8_MMA(1, 1, At, B1); PG8_BAR;
            }
        }
        if constexpr (ALIGN_EPI) { if (wr == 0) PG8_BAR; }
        if constexpr (!Epi::AFTER_DRAIN) { E(acc, cur, wr, wc, fr, fq); S.done(cur); }
        if (!has_next) break;
#pragma unroll
        for (int a = 0; a < 2; ++a)
#pragma unroll
            for (int b = 0; b < 2; ++b)
#pragma unroll
                for (int m = 0; m < 4; ++m)
#pragma unroll
                    for (int n = 0; n < 2; ++n) acc[a][b][m][n] = (f32x4){0.f, 0.f, 0.f, 0.f};
        cur = nxt; cA = nA; cB = nB; ++ui;
        if constexpr (ALIGN_EPI) { if (wr == 1) PG8_BAR; }
    }
    PG8_WAIT_V(0);
    if constexpr (!ALIGN_EPI) { if (wr == 0) PG8_BAR; }
    PG8_BAR;
    if constexpr (Epi::AFTER_DRAIN) { E.fused(acc, cur, wr, wc, fr, fq, lds, wid, lane); S.done(cur); }
#undef PG8_SA
#undef PG8_SB
#undef PG8_STAGE
#undef PG8_LDA
#undef PG8_LDB
#undef PG8_MMA
#undef PG8_WAIT_V
#undef PG8_WAIT_L
#undef PG8_BAR
#undef PG8_SCHED
}
}

constexpr int DM = 1024, SEQ = 4096, NBATCH = 4, MPROMPT = 16384, MSAMP = 128, MTOK = 16512, MPAD = 16640, DFF = 2816, NGU = 5632, NIN = 2816;
constexpr int C_Q = 0, C_K = 512, C_V = 640, C_HQ = 768, C_HF = 1280, C_HI = 1792, C_HG = 2304;
constexpr float EPS = 1e-6f;
constexpr float LOG2E = 1.4426950408889634f;
constexpr float PAST_POS = 8192.0f;
constexpr size_t O_WKP = (size_t)MTOK * DM, O_WVP = O_WKP + 65536, O_SP = O_WVP + 65536, O_WKS = O_SP + 131072, O_WVS = O_WKS + 2097152, O_SS = O_WVS + 2097152;
constexpr size_t MiB = 1u << 20;
constexpr size_t WS_WGU1 = 1 * MiB, WS_WDN1 = 12 * MiB, WS_WIN = 18 * MiB, WS_WOUT = 24 * MiB, WS_WGU2 = 26 * MiB, WS_WDN2 = 37 * MiB;
constexpr size_t WS_LB = 43 * MiB;
constexpr size_t WS_XN = 44 * MiB;
constexpr size_t WS_ACT = 77 * MiB;
constexpr size_t WS_Y = 167 * MiB;
constexpr size_t WS_QE = WS_Y, WS_KE = WS_Y + 16 * MiB, WS_VT = WS_Y + 32 * MiB, WS_UT = WS_Y + 48 * MiB, WS_D = WS_Y + 64 * MiB;
constexpr size_t WS_END = 232 * MiB;
static_assert(WS_XN + (size_t)MPAD * DM * 2 <= WS_ACT && WS_ACT + (size_t)MPAD * DFF * 2 <= WS_Y && WS_Y + (size_t)MPAD * DM * 4 <= WS_END, "ws map");

constexpr int LDS_BYTES = 148480;
constexpr int LDS_BARW = 147456;

#define GAS __attribute__((address_space(1)))
#define LAS __attribute__((address_space(3)))
typedef unsigned short bf16;
typedef unsigned v4u __attribute__((ext_vector_type(4)));
typedef float f32x4 __attribute__((ext_vector_type(4)));
typedef short bf16x8 __attribute__((ext_vector_type(8)));
#define LDS_WAIT() asm volatile("s_waitcnt lgkmcnt(0)" ::: "memory")
#define DI __device__ __forceinline__

DI unsigned f2bf(float f) { unsigned u = __builtin_bit_cast(unsigned, f); return (u + 0x7fffu + ((u >> 16) & 1u)) >> 16; }
DI unsigned pk2(float lo, float hi) { return f2bf(lo) | (f2bf(hi) << 16); }
DI float bf2f(unsigned short h) { return __uint_as_float(((unsigned)h) << 16); }
DI float wave_sum(float v) {
#pragma unroll
    for (int o = 1; o < 64; o <<= 1) v += __shfl_xor(v, o);
    return v;
}
DI float wave_max(float v) {
#pragma unroll
    for (int o = 1; o < 64; o <<= 1) v = fmaxf(v, __shfl_xor(v, o));
    return v;
}
DI float sigmoid_f(float x) { return __builtin_amdgcn_rcpf(1.0f + __expf(-x)); }
DI float silu2_f(float x) { return x * sigmoid_f(x); }
DI void rope_cs(float pos, int i, float& c, float& s) {
    const float inv = __builtin_amdgcn_exp2f(-(float)i * 2.3664460711655217f);
    float rev = (pos * inv) * 0.15915494309189535f;
    rev = rev - floorf(rev);
    s = __builtin_amdgcn_sinf(rev); c = __builtin_amdgcn_cosf(rev);
}
DI void unpack8(const v4u raw, float (&f)[8]) {
#pragma unroll
    for (int i = 0; i < 4; ++i) { f[2 * i] = __uint_as_float(raw[i] << 16); f[2 * i + 1] = __uint_as_float(raw[i] & 0xffff0000u); }
}
DI v4u pack8(const float (&f)[8]) { v4u o; o.x = pk2(f[0], f[1]); o.y = pk2(f[2], f[3]); o.z = pk2(f[4], f[5]); o.w = pk2(f[6], f[7]); return o; }
DI float rope_elem(const bf16* hp, int d, float pos) {
    const int i = d & 7; float c, s; rope_cs(pos, i, c, s);
    const float x1 = bf2f(hp[i]), x2 = bf2f(hp[i + 8]);
    return d < 8 ? x1 * c - x2 * s : x2 * c + x1 * s;
}

template <int MODE> DI void tr_item(const float* W, int K, int N, const float* gain, bf16* WT, LAS float* scr, int item, int lane) {
    const int nblk = N / 32, kb = item / nblk, nb = item % nblk, k0 = 64 * kb, n0 = 32 * nb;
#pragma unroll 8
    for (int i = 0; i < 32; ++i) { const int kk = 2 * i + (lane >> 5); float w = W[(size_t)(k0 + kk) * N + n0 + (lane & 31)]; if (gain) w *= gain[k0 + kk]; scr[kk * 33 + (lane & 31)] = w; }
    LDS_WAIT(); asm volatile("" ::: "memory");
    const int c = lane & 7;
#pragma unroll
    for (int j = 0; j < 4; ++j) { const int n = (lane >> 3) + 8 * j; const LAS float* s = scr + (8 * c) * 33 + n;
        v4u o; o.x = pk2(s[0 * 33], s[1 * 33]); o.y = pk2(s[2 * 33], s[3 * 33]); o.z = pk2(s[4 * 33], s[5 * 33]); o.w = pk2(s[6 * 33], s[7 * 33]);
        const int ns = n0 + n; int drow = ns;
        if (MODE == 1) drow = ns < DFF ? ((ns >> 7) * 256 + (ns & 127)) : (((ns - DFF) >> 7) * 256 + 128 + ((ns - DFF) & 127));
        *(v4u*)(WT + (size_t)drow * K + k0 + 8 * c) = o; }
    LDS_WAIT(); asm volatile("" ::: "memory");
}
DI void norm_row_to_bf16(const float* xrow, bf16* orow, int lane) {
    const f32x4* xr = (const f32x4*)xrow + lane;
    f32x4 v[4]; float s = 0.f;
#pragma unroll
    for (int j = 0; j < 4; ++j) { v[j] = xr[64 * j]; s += (v[j].x * v[j].x + v[j].y * v[j].y) + (v[j].z * v[j].z + v[j].w * v[j].w); }
    const float r = __builtin_amdgcn_rsqf(wave_sum(s) * (1.f / DM) + EPS);
    unsigned long long* o8 = (unsigned long long*)orow + lane;
#pragma unroll
    for (int j = 0; j < 4; ++j) o8[64 * j] = (unsigned long long)pk2(v[j].x * r, v[j].y * r) | ((unsigned long long)pk2(v[j].z * r, v[j].w * r) << 32);
}
DI void resid_row(const float* xrow, const float* yrow, const float* g, float coef, float* orow, bf16* xnrow, int lane) {
    const f32x4* xr = (const f32x4*)xrow + lane; const f32x4* yr = (const f32x4*)yrow + lane; const f32x4* gr = (const f32x4*)g + lane;
    f32x4 xv[4], yv[4]; float s = 0.f;
#pragma unroll
    for (int j = 0; j < 4; ++j) { xv[j] = xr[64 * j]; yv[j] = yr[64 * j]; s += (yv[j].x * yv[j].x + yv[j].y * yv[j].y) + (yv[j].z * yv[j].z + yv[j].w * yv[j].w); }
    const float ry = __builtin_amdgcn_rsqf(wave_sum(s) * (1.f / DM) + EPS) * coef;
    float s2 = 0.f;
#pragma unroll
    for (int j = 0; j < 4; ++j) { const f32x4 gv = gr[64 * j]; xv[j] = xv[j] + (yv[j] * ry) * gv; s2 += (xv[j].x * xv[j].x + xv[j].y * xv[j].y) + (xv[j].z * xv[j].z + xv[j].w * xv[j].w); }
    f32x4* orp = (f32x4*)orow + lane;
#pragma unroll
    for (int j = 0; j < 4; ++j) orp[64 * j] = xv[j];
    if (xnrow) {
        const float r = __builtin_amdgcn_rsqf(wave_sum(s2) * (1.f / DM) + EPS);
        unsigned long long* o8 = (unsigned long long*)xnrow + lane;
#pragma unroll
        for (int j = 0; j < 4; ++j) o8[64 * j] = (unsigned long long)pk2(xv[j].x * r, xv[j].y * r) | ((unsigned long long)pk2(xv[j].z * r, xv[j].w * r) << 32);
    }
}

#define MFMA16(a, b, c) __builtin_amdgcn_mfma_f32_16x16x32_bf16((a), (b), (c), 0, 0, 0)

constexpr int AT_KS = 0, AT_KS_ROW = 144, AT_VT = 36864, AT_VT_ROW = 528, AT_PS = AT_VT + 64 * 528, AT_PS_WAVE = 16 * 528;
static_assert(AT_PS + 8 * AT_PS_WAVE <= LDS_BYTES, "attention LDS");
DI void attn_prompt_unit(LAS unsigned char* lds, const bf16* P, bf16* CAT, const float* sinks, int b, int nbk, int kvh, int tid, int lane, int wave) {
    {
        const int kj = tid >> 1, half = tid & 1; const int t = 128 * (nbk - 1) + kj;
        LAS unsigned char* krow = lds + AT_KS + kj * AT_KS_ROW + half * 64;
        LAS bf16* vt = (LAS bf16*)(lds + AT_VT);
        if (t < 0) {
            const v4u z = (v4u){0u, 0u, 0u, 0u};
#pragma unroll
            for (int c = 0; c < 4; ++c) *(LAS v4u*)(krow + 16 * c) = z;
#pragma unroll
            for (int i = 0; i < 32; ++i) vt[(32 * half + i) * (AT_VT_ROW / 2) + kj] = 0;
        } else {
            const bf16* prow = P + (size_t)(b * SEQ + t) * NIN;
            const v4u* kp = (const v4u*)(prow + C_K + 64 * kvh + 32 * half);
            v4u c0 = kp[0], c1 = kp[1], c2 = kp[2], c3 = kp[3];
            if (half == 0) {
                float x1[8], x2[8], o1[8], o2[8]; unpack8(c0, x1); unpack8(c1, x2);
#pragma unroll
                for (int i = 0; i < 8; ++i) { float c, s; rope_cs((float)t, i, c, s); o1[i] = x1[i] * c - x2[i] * s; o2[i] = x2[i] * c + x1[i] * s; }
                c0 = pack8(o1); c1 = pack8(o2);
            }
            *(LAS v4u*)(krow) = c0; *(LAS v4u*)(krow + 16) = c1; *(LAS v4u*)(krow + 32) = c2; *(LAS v4u*)(krow + 48) = c3;
            const v4u* vp = (const v4u*)(prow + C_V + 64 * kvh + 32 * half);
#pragma unroll
            for (int c = 0; c < 4; ++c) { const v4u raw = vp[c];
#pragma unroll
                for (int i = 0; i < 4; ++i) { vt[(32 * half + 8 * c + 2 * i) * (AT_VT_ROW / 2) + kj] = (bf16)(raw[i] & 0xffffu); vt[(32 * half + 8 * c + 2 * i + 1) * (AT_VT_ROW / 2) + kj] = (bf16)(raw[i] >> 16); } }
        }
    }
    __syncthreads();
    const int g = wave >> 1, qhalf = wave & 1, h = 4 * kvh + g, fr = lane & 15, fq = lane >> 4;
    const float sink2 = sinks[h] * LOG2E;
    LAS unsigned char* ps = lds + AT_PS + wave * AT_PS_WAVE;
#pragma unroll 1
    for (int sb = 0; sb < 4; ++sb) {
        const int q0 = 64 * qhalf + 16 * sb;
        bf16x8 qa[2];
        {
            const int qi = q0 + fr; const int t = 128 * nbk + qi;
            const bf16* qp = P + (size_t)(b * SEQ + t) * NIN + C_Q + 64 * h;
            v4u r0 = *(const v4u*)(qp + 8 * fq), r1 = *(const v4u*)(qp + 32 + 8 * fq);
            if (fq < 2) {
                const v4u other = *(const v4u*)(qp + 8 * (fq ^ 1));
                float a[8], o[8], x[8]; unpack8(r0, a); unpack8(other, o);
#pragma unroll
                for (int i = 0; i < 8; ++i) { float c, s; rope_cs((float)t, i, c, s); x[i] = fq == 0 ? a[i] * c - o[i] * s : a[i] * c + o[i] * s; }
                r0 = pack8(x);
            }
            qa[0] = __builtin_bit_cast(bf16x8, r0); qa[1] = __builtin_bit_cast(bf16x8, r1);
        }
        f32x4 sc[16];
#pragma unroll
        for (int n = 0; n < 16; ++n) {
            sc[n] = (f32x4){0.f, 0.f, 0.f, 0.f};
#pragma unroll
            for (int ks = 0; ks < 2; ++ks) { const bf16x8 kb = *(const LAS bf16x8*)(lds + AT_KS + (16 * n + fr) * AT_KS_ROW + (32 * ks + 8 * fq) * 2); sc[n] = MFMA16(qa[ks], kb, sc[n]); }
        }
        float mx[4], sm[4];
#pragma unroll
        for (int j = 0; j < 4; ++j) {
            const int qi = q0 + 4 * fq + j; float m = -1e30f;
#pragma unroll
            for (int n = 0; n < 16; ++n) { const int kj = 16 * n + fr; const bool valid = (kj > qi) && (kj <= qi + 128) && (nbk > 0 || kj >= 128);
                const float v = valid ? sc[n][j] * (0.125f * LOG2E) : -1e30f; sc[n][j] = v; m = fmaxf(m, v); }
            m = fmaxf(m, __shfl_xor(m, 1)); m = fmaxf(m, __shfl_xor(m, 2)); m = fmaxf(m, __shfl_xor(m, 4)); m = fmaxf(m, __shfl_xor(m, 8));
            m = fmaxf(m, sink2); mx[j] = m;
            float s = 0.f;
#pragma unroll
            for (int n = 0; n < 16; ++n) { const float p = __builtin_amdgcn_exp2f(sc[n][j] - m); sc[n][j] = p; s += p; }
            s += __shfl_xor(s, 1); s += __shfl_xor(s, 2); s += __shfl_xor(s, 4); s += __shfl_xor(s, 8);
            sm[j] = __builtin_amdgcn_rcpf(s + __builtin_amdgcn_exp2f(sink2 - m));
        }
#pragma unroll
        for (int n = 0; n < 16; ++n)
#pragma unroll
            for (int j = 0; j < 4; ++j) *(LAS bf16*)(ps + (4 * fq + j) * AT_VT_ROW + (16 * n + fr) * 2) = (bf16)f2bf(sc[n][j]);
        LDS_WAIT(); asm volatile("" ::: "memory");
        f32x4 o[4];
#pragma unroll
        for (int n = 0; n < 4; ++n) o[n] = (f32x4){0.f, 0.f, 0.f, 0.f};
#pragma unroll
        for (int ks = 0; ks < 8; ++ks) { const bf16x8 pa = *(const LAS bf16x8*)(ps + fr * AT_VT_ROW + (32 * ks + 8 * fq) * 2);
#pragma unroll
            for (int n = 0; n < 4; ++n) { const bf16x8 vb = *(const LAS bf16x8*)(lds + AT_VT + (16 * n + fr) * AT_VT_ROW + (32 * ks + 8 * fq) * 2); o[n] = MFMA16(pa, vb, o[n]); } }
        LDS_WAIT(); asm volatile("" ::: "memory");
#pragma unroll
        for (int j = 0; j < 4; ++j) { bf16* op = CAT + (size_t)(b * SEQ + 128 * nbk + q0 + 4 * fq + j) * DM + 64 * h + fr;
#pragma unroll
            for (int n = 0; n < 4; ++n) op[16 * n] = (bf16)f2bf(o[n][j] * sm[j]); }
    }
    __syncthreads();
}

constexpr int HG_ROW = 144, HG_WAVE_LDS = 18432;
DI void hgrn_gate_unit(LAS unsigned char* ldsw, const bf16* P, const float* lbv, bf16* QE, bf16* KE, bf16* VTg, bf16* UT, float* Dws, int b, int h, int c, int lane) {
    const int r0 = b * SEQ + 64 * c, unit = (b * 8 + h) * 64 + c, fr = lane & 15, fq = lane >> 4;
    const float lb = lbv[64 * h + lane];
    const bf16* pp = P + (size_t)r0 * NIN + 64 * h + lane;
    bf16* qep = QE + (size_t)r0 * 512 + 64 * h + lane; bf16* kep = KE + (size_t)r0 * 512 + 64 * h + lane;
    {
        unsigned w[64];
#pragma unroll
        for (int t = 0; t < 64; ++t) w[t] = pp[(size_t)t * NIN + C_HI];
#pragma unroll
        for (int s8 = 0; s8 < 8; ++s8) {
            const v4u o = (v4u){w[8 * s8] | (w[8 * s8 + 1] << 16), w[8 * s8 + 2] | (w[8 * s8 + 3] << 16), w[8 * s8 + 4] | (w[8 * s8 + 5] << 16), w[8 * s8 + 6] | (w[8 * s8 + 7] << 16)};
            *(LAS v4u*)(ldsw + 9216 + lane * HG_ROW + 16 * s8) = o;
            *(v4u*)(VTg + (size_t)unit * 4096 + lane * 64 + 8 * s8) = o; }
    }
    float ke[64]; float run = 0.f;
    {
        unsigned short hfr[64], hqr[64];
#pragma unroll
        for (int t = 0; t < 64; ++t) { hfr[t] = pp[(size_t)t * NIN + C_HF]; hqr[t] = pp[(size_t)t * NIN + C_HQ]; }
#pragma unroll
        for (int t = 0; t < 64; ++t) {
            const float hf = bf2f(hfr[t]), hq = bf2f(hqr[t]);
            const float f = lb + (1.0f - lb) * sigmoid_f(hf); run += __logf(f);
            qep[t * 512] = (bf16)f2bf(hq * 0.125f * __expf(run));
            const float k_ = (1.0f - f) * __expf(-run); kep[t * 512] = (bf16)f2bf(k_); ke[t] = k_;
        }
    }
    const float D = __expf(run);
    Dws[(size_t)unit * 64 + lane] = D;
#pragma unroll
    for (int s8 = 0; s8 < 8; ++s8) { float kd[8];
#pragma unroll
        for (int i = 0; i < 8; ++i) kd[i] = ke[8 * s8 + i] * D;
        *(LAS v4u*)(ldsw + lane * HG_ROW + 16 * s8) = pack8(kd); }
    LDS_WAIT(); asm volatile("" ::: "memory");
    bf16x8 vb[4][2];
#pragma unroll
    for (int nb = 0; nb < 4; ++nb)
#pragma unroll
        for (int ks = 0; ks < 2; ++ks) vb[nb][ks] = *(const LAS bf16x8*)(ldsw + 9216 + (16 * nb + fr) * HG_ROW + (32 * ks + 8 * fq) * 2);
#pragma unroll
    for (int mb = 0; mb < 4; ++mb) {
        bf16x8 ka[2];
#pragma unroll
        for (int ks = 0; ks < 2; ++ks) ka[ks] = *(const LAS bf16x8*)(ldsw + (16 * mb + fr) * HG_ROW + (32 * ks + 8 * fq) * 2);
#pragma unroll
        for (int nb = 0; nb < 4; ++nb) { f32x4 acc = (f32x4){0.f, 0.f, 0.f, 0.f};
            acc = MFMA16(ka[0], vb[nb][0], acc); acc = MFMA16(ka[1], vb[nb][1], acc);
            uint2 o; o.x = pk2(acc[0], acc[1]); o.y = pk2(acc[2], acc[3]);
            *(uint2*)(UT + (size_t)unit * 4096 + (16 * nb + fr) * 64 + 16 * mb + 4 * fq) = o; }
    }
    LDS_WAIT(); asm volatile("" ::: "memory");
}
DI void hgrn_out_unit(const bf16* P, const bf16* QE, const bf16* KE, const bf16* VTg, const bf16* SPT, const float* outg, bf16* CAT, int b, int h, int c, int lane) {
    const int r0 = b * SEQ + 64 * c, unit = (b * 8 + h) * 64 + c, fr = lane & 15, fq = lane >> 4;
    const bf16* qep = QE + (size_t)r0 * 512 + 64 * h; const bf16* kep = KE + (size_t)r0 * 512 + 64 * h;
    const bf16* vtp = VTg + (size_t)unit * 4096; const bf16* spp = SPT + (size_t)unit * 4096;
    bf16x8 spa[4][2], vta[4][2];
#pragma unroll
    for (int mb = 0; mb < 4; ++mb)
#pragma unroll
        for (int ks = 0; ks < 2; ++ks) {
            spa[mb][ks] = *(const bf16x8*)(spp + (16 * mb + fr) * 64 + 32 * ks + 8 * fq);
            const uint2 lo = *(const uint2*)(vtp + (16 * mb + fr) * 64 + 32 * ks + 4 * fq), hi = *(const uint2*)(vtp + (16 * mb + fr) * 64 + 32 * ks + 16 + 4 * fq);
            vta[mb][ks] = __builtin_bit_cast(bf16x8, ((v4u){lo.x, lo.y, hi.x, hi.y}));
        }
    f32x4 og[4];
#pragma unroll
    for (int mb = 0; mb < 4; ++mb) og[mb] = *(const f32x4*)(outg + 16 * mb + 4 * fq);
    bf16x8 qbs[4][2], kas[4][2];
#pragma unroll
    for (int nb = 0; nb < 4; ++nb)
#pragma unroll
        for (int ks = 0; ks < 2; ++ks) { qbs[nb][ks] = *(const bf16x8*)(qep + (size_t)(16 * nb + fr) * 512 + 32 * ks + 8 * fq); kas[nb][ks] = *(const bf16x8*)(kep + (size_t)(16 * nb + fr) * 512 + 32 * ks + 8 * fq); }
#pragma unroll
    for (int nb = 0; nb < 4; ++nb) {
        uint2 hgs[4];
#pragma unroll
        for (int mb = 0; mb < 4; ++mb) hgs[mb] = *(const uint2*)(P + (size_t)(r0 + 16 * nb + fr) * NIN + C_HG + 64 * h + 16 * mb + 4 * fq);
        f32x4 at[4];
#pragma unroll
        for (int sb = 0; sb < 4; ++sb) { at[sb] = (f32x4){0.f, 0.f, 0.f, 0.f};
            if (sb <= nb) {
                at[sb] = MFMA16(kas[sb][0], qbs[nb][0], at[sb]); at[sb] = MFMA16(kas[sb][1], qbs[nb][1], at[sb]);
                if (sb == nb) {
#pragma unroll
                    for (int j = 0; j < 4; ++j) if (4 * fq + j > fr) at[sb][j] = 0.f;
                }
            } }
        bf16x8 bat[2];
#pragma unroll
        for (int p = 0; p < 2; ++p) bat[p] = __builtin_bit_cast(bf16x8, ((v4u){pk2(at[2 * p][0], at[2 * p][1]), pk2(at[2 * p][2], at[2 * p][3]), pk2(at[2 * p + 1][0], at[2 * p + 1][1]), pk2(at[2 * p + 1][2], at[2 * p + 1][3])}));
        f32x4 o[4]; float ss = 0.f;
#pragma unroll
        for (int mb = 0; mb < 4; ++mb) { o[mb] = (f32x4){0.f, 0.f, 0.f, 0.f};
            o[mb] = MFMA16(spa[mb][0], qbs[nb][0], o[mb]); o[mb] = MFMA16(spa[mb][1], qbs[nb][1], o[mb]);
            o[mb] = MFMA16(vta[mb][0], bat[0], o[mb]); if (nb >= 2) o[mb] = MFMA16(vta[mb][1], bat[1], o[mb]);
            ss += (o[mb][0] * o[mb][0] + o[mb][1] * o[mb][1]) + (o[mb][2] * o[mb][2] + o[mb][3] * o[mb][3]); }
        ss += __shfl_xor(ss, 16); ss += __shfl_xor(ss, 32);
        const float r = __builtin_amdgcn_rsqf(ss * (1.0f / 64.0f) + EPS);
        const size_t row = (size_t)(r0 + 16 * nb + fr);
#pragma unroll
        for (int mb = 0; mb < 4; ++mb) {
            const uint2 hgr = hgs[mb];
            const float g0 = __uint_as_float(hgr.x << 16), g1 = __uint_as_float(hgr.x & 0xffff0000u), g2 = __uint_as_float(hgr.y << 16), g3 = __uint_as_float(hgr.y & 0xffff0000u);
            uint2 w; w.x = pk2(o[mb][0] * r * og[mb][0] * silu2_f(g0), o[mb][1] * r * og[mb][1] * silu2_f(g1)); w.y = pk2(o[mb][2] * r * og[mb][2] * silu2_f(g2), o[mb][3] * r * og[mb][3] * silu2_f(g3));
            *(uint2*)(CAT + row * DM + 512 + 64 * h + 16 * mb + 4 * fq) = w; }
    }
}

constexpr int SA_KL = 0, SA_VL = 33280, SA_QL = 66048, SA_SL = 67072, SA_RL = 69120;
DI void attn_sample_unit(LAS unsigned char* lds, const bf16* P, const float* cache_k, const float* cache_v, const float* sinks, float* out, bf16* CAT, int b, int kvh, int tid, int lane, int wave) {
    LAS float* KL = (LAS float*)(lds + SA_KL); LAS float* VL = (LAS float*)(lds + SA_VL); LAS float* QL = (LAS float*)(lds + SA_QL); LAS float* SL = (LAS float*)(lds + SA_SL); LAS float* RL = (LAS float*)(lds + SA_RL);
    const bf16* prow = P + (size_t)(MPROMPT + b) * NIN;
#pragma unroll 4
    for (int i = 0; i < 16; ++i) { const int idx = tid + 512 * i, key = idx >> 6, d = idx & 63; float kv, vv;
        if (key < 127) { const size_t src = ((size_t)(b * 128 + key + 1) * 2 + kvh) * 64 + d; kv = cache_k[src]; vv = cache_v[src]; }
        else { const bf16* hp = prow + C_K + 64 * kvh; kv = d < 16 ? rope_elem(hp, d, PAST_POS) : bf2f(hp[d]); vv = bf2f(prow[C_V + 64 * kvh + d]); }
        KL[key * 65 + d] = kv; VL[key * 64 + d] = vv;
        const size_t dst = ((size_t)(b * 128 + key) * 2 + kvh) * 64 + d; out[O_WKS + dst] = kv; out[O_WVS + dst] = vv; }
    if (tid < 256) { const int g = tid >> 6, d = tid & 63; const bf16* hp = prow + C_Q + 64 * (4 * kvh + g);
        const float q = d < 16 ? rope_elem(hp, d, PAST_POS) : bf2f(hp[d]); QL[g * 64 + d] = q * (0.125f * LOG2E); }
    __syncthreads();
    { const int g = tid >> 7, j = tid & 127; float s = 0.f;
#pragma unroll 16
      for (int d = 0; d < 64; ++d) s += QL[g * 64 + d] * KL[j * 65 + d];
      SL[g * 128 + j] = s; }
    __syncthreads();
    if (wave < 4) { const int g = wave; const float sink2 = sinks[4 * kvh + g] * LOG2E; const float s0 = SL[g * 128 + lane], s1 = SL[g * 128 + 64 + lane];
        const float m = fmaxf(wave_max(fmaxf(s0, s1)), sink2); const float p0 = __builtin_amdgcn_exp2f(s0 - m), p1 = __builtin_amdgcn_exp2f(s1 - m);
        const float sum = wave_sum(p0 + p1) + __builtin_amdgcn_exp2f(sink2 - m); SL[g * 128 + lane] = p0; SL[g * 128 + 64 + lane] = p1; if (lane == 0) RL[g] = 1.0f / sum; }
    __syncthreads();
    if (tid < 256) { const int g = tid >> 6, d = tid & 63; float o = 0.f;
#pragma unroll 16
        for (int j = 0; j < 128; ++j) o += SL[g * 128 + j] * VL[j * 64 + d];
        CAT[(size_t)(MPROMPT + b) * DM + 64 * (4 * kvh + g) + d] = (bf16)f2bf(o * RL[g]); }
    __syncthreads();
}
DI void hgrn_sample_unit(const bf16* P, const float* lbv, const float* state, const float* outg, float* out, bf16* CAT, int b, int h, int lane) {
    const bf16* prow = P + (size_t)(MPROMPT + b) * NIN + 64 * h + lane;
    const float lb = lbv[64 * h + lane];
    const float q = bf2f(prow[C_HQ]) * 0.125f, f = lb + (1.0f - lb) * sigmoid_f(bf2f(prow[C_HF])), kk = 1.0f - f, v = bf2f(prow[C_HI]), hg = bf2f(prow[C_HG]);
    const float* S = state + (size_t)(b * 8 + h) * 4096 + lane; float* So = out + O_SS + (size_t)(b * 8 + h) * 4096 + lane;
    float o = 0.f; float sv[64];
#pragma unroll
    for (int k = 0; k < 64; ++k) sv[k] = S[k * 64];
#pragma unroll
    for (int k = 0; k < 64; ++k) { const float fk = __shfl(f, k), kkk = __shfl(kk, k), qk = __shfl(q, k); const float sn = fk * sv[k] + kkk * v; So[k * 64] = sn; o += qk * sn; }
    const float r = __builtin_amdgcn_rsqf(wave_sum(o * o) * (1.0f / 64.0f) + EPS);
    CAT[(size_t)(MPROMPT + b) * DM + 512 + 64 * h + lane] = (bf16)f2bf(o * r * outg[lane] * silu2_f(hg));
}

#define XB_TMO      128
#define XB_XCNT(j)  (256  + 64 * (j))
#define XB_XSUB(j)  (1280 + 64 * (j))
#define XB_XGEN(j)  (2304 + 64 * (j))
#define XB_TOP      3328
#define XB_TOPGEN   3392
#define XCD_BAR_WORDS 3456
#define XB_SPIN_CAP (1u << 18)

__device__ __forceinline__ unsigned xb_ld(unsigned* p)              { return __hip_atomic_load(p, __ATOMIC_RELAXED, __HIP_MEMORY_SCOPE_AGENT); }
__device__ __forceinline__ unsigned xb_add(unsigned* p, unsigned v) { return __hip_atomic_fetch_add(p, v, __ATOMIC_RELAXED, __HIP_MEMORY_SCOPE_AGENT); }
__device__ __forceinline__ unsigned xb_xcc_id() { return (unsigned)__builtin_amdgcn_s_getreg((3 << 11) | 20) & 0xFu; }
#define XB_SPIN(cond, bar) do { unsigned _sp = 0; while (cond) { __builtin_amdgcn_s_sleep(1); \
    if ((++_sp & 255u) == 0u) { if (xb_ld(&(bar)[XB_TMO])) break; if (_sp > XB_SPIN_CAP) { atomicAdd(&(bar)[XB_TMO], 1u); break; } } } } while (0)

struct XcdBarrier {
    unsigned* bar; unsigned x;
    volatile LAS unsigned* st;
};

__device__ __forceinline__ XcdBarrier xcd_barrier_post(unsigned* bar, volatile LAS unsigned* st) {
    XcdBarrier b; b.bar = bar; b.x = xb_xcc_id(); b.st = st;
    if (threadIdx.x == 0) (void)xb_add(&bar[XB_XCNT(b.x)], 1u);
    return b;
}
__device__ __forceinline__ void xcd_barrier_complete(unsigned* bar, unsigned x, unsigned& nloc, unsigned& nx) {
    const unsigned G = gridDim.x * gridDim.y * gridDim.z;
    unsigned sum, cnt, mine, sp = 0u;
    for (;;) {
        sum = 0u; cnt = 0u; mine = 0u;
#pragma unroll
        for (unsigned j = 0; j < 16; ++j) { const unsigned c = xb_ld(&bar[XB_XCNT(j)]); sum += c; cnt += (c > 0u) ? 1u : 0u; mine = (j == x) ? c : mine; }
        if (sum == G) break;
        __builtin_amdgcn_s_sleep(1);
        if ((++sp & 255u) == 0u) { if (xb_ld(&bar[XB_TMO])) break; if (sp > XB_SPIN_CAP) { atomicAdd(&bar[XB_TMO], 1u); break; } }
    }
    nloc = mine > 0u ? mine : 1u; nx = cnt > 0u ? cnt : 1u;
}

__device__ __forceinline__ void xcd_barrier(const XcdBarrier& b) {
    asm volatile("s_waitcnt vmcnt(0)" ::: "memory");
    __syncthreads();
    if (threadIdx.x == 0) {
        unsigned* bar = b.bar;
        __builtin_amdgcn_s_waitcnt(0);
        unsigned nloc = b.st[0], nx = b.st[1];
        if (nloc == 0u) { xcd_barrier_complete(bar, b.x, nloc, nx); b.st[0] = nloc; b.st[1] = nx; }
        const unsigned old = xb_add(&bar[XB_XSUB(b.x)], 1u);
        const unsigned gen = old / nloc;
        if (old + 1u == (gen + 1u) * nloc) {
            __builtin_amdgcn_fence(__ATOMIC_RELEASE, "agent");
            asm volatile("s_waitcnt vmcnt(0)" ::: "memory");
            const unsigned og = xb_add(&bar[XB_TOP], 1u);
            const unsigned tg = og / nx;
            if (og + 1u == (tg + 1u) * nx) xb_add(&bar[XB_TOPGEN], 1u);
            else XB_SPIN(xb_ld(&bar[XB_TOPGEN]) == tg, bar);
            __builtin_amdgcn_fence(__ATOMIC_ACQUIRE, "agent");
            xb_add(&bar[XB_XGEN(b.x)], 1u);
            asm volatile("s_waitcnt vmcnt(0)" ::: "memory");
        } else {
            XB_SPIN(xb_ld(&bar[XB_XGEN(b.x)]) == gen, bar);
            __builtin_amdgcn_fence(__ATOMIC_ACQUIRE, "agent");
            asm volatile("s_waitcnt vmcnt(0)" ::: "memory");
        }
    }
    __syncthreads();
}

struct Args { const float* in[20]; float* out; unsigned char* ws; };
__global__ void __launch_bounds__(512, 2) mk_fwd(Args args) {
    extern __shared__ __attribute__((aligned(16))) unsigned char lds_raw[];
    cg::grid_group grid = cg::this_grid();
    LAS unsigned char* lds = (LAS unsigned char*)lds_raw;
    const int tid = threadIdx.x, lane = tid & 63, wave = __builtin_amdgcn_readfirstlane(tid >> 6);
    const int G = gridDim.x, bid = blockIdx.x, gw = bid * 8 + wave, NGW = G * 8;
    unsigned char* ws = args.ws; float* out = args.out;
    const float* x_prompt = args.in[0]; const float* x_sample = args.in[1];
    bf16* Wgu1 = (bf16*)(ws + WS_WGU1); bf16* Wdn1 = (bf16*)(ws + WS_WDN1); bf16* Win = (bf16*)(ws + WS_WIN); bf16* Wout = (bf16*)(ws + WS_WOUT);
    bf16* Wgu2 = (bf16*)(ws + WS_WGU2); bf16* Wdn2 = (bf16*)(ws + WS_WDN2);
    float* LBV = (float*)(ws + WS_LB); bf16* XN = (bf16*)(ws + WS_XN); bf16* ACT = (bf16*)(ws + WS_ACT); float* Y = (float*)(ws + WS_Y);
    bf16* QE = (bf16*)(ws + WS_QE); bf16* KE = (bf16*)(ws + WS_KE); bf16* VTg = (bf16*)(ws + WS_VT); bf16* UT = (bf16*)(ws + WS_UT); float* Dws = (float*)(ws + WS_D);
    if (tid < 4) ((volatile LAS unsigned*)(lds + LDS_BARW))[tid] = 0u;
    if (bid == 0) for (int i = tid; i < XCD_BAR_WORDS; i += 512) __hip_atomic_store((unsigned*)ws + i, 0u, __ATOMIC_RELAXED, __HIP_MEMORY_SCOPE_AGENT);
    __syncthreads();


    for (int rep = 0; rep < REP_P0; ++rep) {
        LAS float* scr = (LAS float*)(lds + wave * 16384);
        constexpr int I_GU = 16 * 176, I_DN = 44 * 32, I_IN = 16 * 88, I_OUT = 16 * 32, NITEMS = 2 * I_GU + 2 * I_DN + I_IN + I_OUT;
        for (int it = gw; it < NITEMS; it += NGW) {
            int r = it;
            if (r < I_GU) { tr_item<1>(args.in[7], DM, NGU, args.in[5], Wgu1, scr, r, lane); continue; } r -= I_GU;
            if (r < I_GU) { tr_item<1>(args.in[18], DM, NGU, args.in[16], Wgu2, scr, r, lane); continue; } r -= I_GU;
            if (r < I_DN) { tr_item<0>(args.in[8], DFF, DM, nullptr, Wdn1, scr, r, lane); continue; } r -= I_DN;
            if (r < I_DN) { tr_item<0>(args.in[19], DFF, DM, nullptr, Wdn2, scr, r, lane); continue; } r -= I_DN;
            if (r < I_IN) { tr_item<0>(args.in[11], DM, NIN, args.in[9], Win, scr, r, lane); continue; } r -= I_IN;
            tr_item<0>(args.in[15], DM, DM, nullptr, Wout, scr, r, lane);
        }
        for (int m = gw; m < MPAD; m += NGW) {
            if (m < MTOK) norm_row_to_bf16(m < MPROMPT ? x_prompt + (size_t)m * DM : x_sample + (size_t)(m - MPROMPT) * DM, XN + (size_t)m * DM, lane);
            else { unsigned long long* o8 = (unsigned long long*)(XN + (size_t)m * DM) + lane;
#pragma unroll
                for (int j = 0; j < 4; ++j) o8[64 * j] = 0ull; }
        }
        if (bid == 0) { const float* l = args.in[13]; LBV[tid] = 1.0f / (1.0f + __expf(l[512 + tid] - l[tid])); }
    }
    grid.sync();
    const XcdBarrier xbar = xcd_barrier_post((unsigned*)ws, (volatile LAS unsigned*)(lds + LDS_BARW));
    { pg8::Gemm g{XN, Wgu1, MPAD, NGU, DM}; pg8::StaticOrder S; S.init(MPAD, NGU, G, bid); pg8::EpiSwiGLU E{ACT, DFF};
      pg8::gemm_phase<pg8::EpiSwiGLU, pg8::StaticOrder, true, true>(lds, g, S, E); }
    xcd_barrier(xbar);
    { pg8::Gemm g{ACT, Wdn1, MPAD, DM, DFF}; pg8::StaticOrder S; S.init(MPAD, DM, G, bid); pg8::EpiF32 E{Y, DM};
      pg8::gemm_phase<pg8::EpiF32, pg8::StaticOrder, true, true>(lds, g, S, E); }
    xcd_barrier(xbar);
    for (int rep = 0; rep < REP_P3; ++rep)
    for (int m = gw; m < MTOK; m += NGW)
        resid_row(m < MPROMPT ? x_prompt + (size_t)m * DM : x_sample + (size_t)(m - MPROMPT) * DM, Y + (size_t)m * DM, args.in[6], 0.5f, out + (size_t)m * DM, XN + (size_t)m * DM, lane);
    xcd_barrier(xbar);
    { pg8::Gemm g{XN, Win, MPAD, NIN, DM}; pg8::StaticOrder S; S.init(MPAD, NIN, G, bid); pg8::EpiBf16 E{ACT, NIN};
      pg8::gemm_phase<pg8::EpiBf16, pg8::StaticOrder, true, true>(lds, g, S, E); }
    xcd_barrier(xbar);
    for (int rep = 0; rep < REP_MIX; ++rep) {
    {
        const bf16* P = ACT; bf16* CAT = XN;
        for (int u = bid; u < 256; u += G) attn_prompt_unit(lds, P, CAT, args.in[12], u >> 6, (u >> 1) & 31, u & 1, tid, lane, wave);
        for (int u = gw; u < 2048; u += NGW) hgrn_gate_unit(lds + wave * HG_WAVE_LDS, P, LBV, QE, KE, VTg, UT, Dws, u >> 9, (u >> 6) & 7, u & 63, lane);
        __syncthreads();
        for (int u = bid; u < 256; u += G) attn_sample_unit(lds, P, args.in[2], args.in[3], args.in[12], out, CAT, u >> 1, u & 1, tid, lane, wave);
        for (int u = gw; u < 1024; u += NGW) hgrn_sample_unit(P, LBV, args.in[4], args.in[14], out, CAT, u >> 3, u & 7, lane);
        for (int e = bid * 512 + tid; e < 131072; e += G * 512) {
            const int which = e >> 16, r = e & 65535, b = r >> 14, j = (r >> 7) & 127, kvh = (r >> 6) & 1, d = r & 63;
            const bf16* prow = P + (size_t)(b * SEQ + SEQ - 128 + j) * NIN;
            float v;
            if (which == 0) { const bf16* hp = prow + C_K + 64 * kvh; v = d < 16 ? rope_elem(hp, d, (float)(SEQ - 128 + j)) : bf2f(hp[d]); }
            else v = bf2f(prow[C_V + 64 * kvh + d]);
            out[O_WKP + e] = v;
        }
    }
    xcd_barrier(xbar);
    for (int e = bid * 512 + tid; e < 65536; e += G * 512) {
        const int bh = e >> 11, pr = e & 2047, k0 = (2 * pr) & 63, dv = (2 * pr) >> 6; float S0 = 0.f, S1 = 0.f;
        unsigned* up = (unsigned*)(UT + (size_t)bh * 64 * 4096) + pr; const float* dp = Dws + (size_t)bh * 64 * 64 + k0;
#pragma unroll 1
        for (int c0 = 0; c0 < 64; c0 += 32) { unsigned raw[32]; float2 dd[32];
#pragma unroll
            for (int c = 0; c < 32; ++c) { raw[c] = up[(size_t)(c0 + c) * 2048]; dd[c] = *(const float2*)(dp + (c0 + c) * 64); }
#pragma unroll
            for (int c = 0; c < 32; ++c) { up[(size_t)(c0 + c) * 2048] = pk2(S0, S1); S0 = dd[c].x * S0 + __uint_as_float(raw[c] << 16); S1 = dd[c].y * S1 + __uint_as_float(raw[c] & 0xffff0000u); } }
        out[O_SP + (size_t)bh * 4096 + k0 * 64 + dv] = S0; out[O_SP + (size_t)bh * 4096 + (k0 + 1) * 64 + dv] = S1;
    }
    xcd_barrier(xbar);
    {
        const bf16* P = ACT; bf16* CAT = XN;
        for (int u = gw; u < 2048; u += NGW) hgrn_out_unit(P, QE, KE, VTg, UT, args.in[14], CAT, u >> 9, (u >> 6) & 7, u & 63, lane);
    }
    xcd_barrier(xbar);
    }
    { pg8::Gemm g{XN, Wout, MPAD, DM, DM}; pg8::StaticOrder S; S.init(MPAD, DM, G, bid); pg8::EpiF32 E{Y, DM};
      pg8::gemm_phase<pg8::EpiF32, pg8::StaticOrder, true, true>(lds, g, S, E); }
    xcd_barrier(xbar);
    for (int m = gw; m < MTOK; m += NGW) resid_row(out + (size_t)m * DM, Y + (size_t)m * DM, args.in[10], 1.0f, out + (size_t)m * DM, XN + (size_t)m * DM, lane);
    xcd_barrier(xbar);
    { pg8::Gemm g{XN, Wgu2, MPAD, NGU, DM}; pg8::StaticOrder S; S.init(MPAD, NGU, G, bid); pg8::EpiSwiGLU E{ACT, DFF};
      pg8::gemm_phase<pg8::EpiSwiGLU, pg8::StaticOrder, true, true>(lds, g, S, E); }
    xcd_barrier(xbar);
    { pg8::Gemm g{ACT, Wdn2, MPAD, DM, DFF}; pg8::StaticOrder S; S.init(MPAD, DM, G, bid); pg8::EpiF32 E{Y, DM};
      pg8::gemm_phase<pg8::EpiF32, pg8::StaticOrder, true, true>(lds, g, S, E); }
    xcd_barrier(xbar);
    for (int m = gw; m < MTOK; m += NGW) resid_row(out + (size_t)m * DM, Y + (size_t)m * DM, args.in[17], 0.5f, out + (size_t)m * DM, nullptr, lane);
}

extern "C" void kernel_launch(void* const* d_in, const int* in_sizes, int n_in, void* d_out, int out_size, void* d_ws, size_t ws_size, hipStream_t stream) {
    static int grid = 0;
    if (grid == 0) {
        int dev = 0, cus = 0, per_cu = 0;
        (void)hipGetDevice(&dev);
        (void)hipDeviceGetAttribute(&cus, hipDeviceAttributeMultiprocessorCount, dev);
        (void)hipFuncSetAttribute((const void*)mk_fwd, hipFuncAttributeMaxDynamicSharedMemorySize, LDS_BYTES);
        if (hipOccupancyMaxActiveBlocksPerMultiprocessor(&per_cu, (const void*)mk_fwd, 512, LDS_BYTES) != hipSuccess || per_cu < 1) { fprintf(stderr, "occupancy query: %d blocks per CU\n", per_cu); per_cu = 1; }
        (void)hipGetLastError();
        grid = cus * (per_cu > 1 ? 1 : per_cu);
        if (n_in != 20 || ws_size < WS_END) { fprintf(stderr, "kernel_launch: unexpected inputs (n_in %d, ws %zu)\n", n_in, ws_size); grid = -1; }
    }
    if (grid < 0) return;
    Args a{};
    for (int i = 0; i < 20; ++i) a.in[i] = (const float*)d_in[i];
    a.out = (float*)d_out; a.ws = (unsigned char*)d_ws;
    void* kargs[] = {&a};
    hipError_t e = hipLaunchCooperativeKernel((const void*)mk_fwd, dim3(grid), dim3(512), kargs, LDS_BYTES, stream);
    if (e != hipSuccess) fprintf(stderr, "cooperative launch failed: %s (grid %d)\n", hipGetErrorString(e), grid);
}
```

```cpp
#include <hip/hip_runtime.h>
#include <hip/hip_cooperative_groups.h>
#include <cstdio>
#include <cstdint>
namespace cg = cooperative_groups;
#ifndef REP_P0
#define REP_P0 1
#endif
#ifndef REP_MIX
#define REP_MIX 1
#endif
#ifndef REP_P3
#define REP_P3 1
#endif
namespace pg8 {
#define PG8_LAS __attribute__((address_space(3)))
typedef unsigned short bf16_t;
typedef short bf16x8 __attribute__((ext_vector_type(8)));
typedef float f32x4 __attribute__((ext_vector_type(4)));
typedef unsigned u32x4 __attribute__((ext_vector_type(4)));
constexpr int BM = 256, BK = 64, HALF = 128, HTB = HALF * BK * 2  , STAGE_BYTES = 8 * HTB, NXCD = 8, WGM = 8;

__host__ __device__ __forceinline__ int lds_byte(int r, int c) { const int st = (r >> 4) * 2 + (c >> 5), rr = r & 15, cc = c & 31, ob = rr * 64 + cc * 2; return st * 1024 + (ob ^ (((ob >> 9) & 1) << 5)); }
__host__ __device__ __forceinline__ void stage_rc(int b, int& R, int& C) { const int st = b / 1024, sb = b % 1024, swz = sb ^ (((sb >> 9) & 1) << 5); R = (st >> 1) * 16 + swz / 64; C = (st & 1) * 32 + (swz % 64) / 2; }
__host__ __device__ __forceinline__ int perm32(int rho) { const int n = rho >> 4, i = rho & 15; return 8 * (i >> 2) + 4 * n + (i & 3); }

struct Unit { int pm, pn, k0; };
struct Gemm { const bf16_t* A; const bf16_t* Bt; int M, N, K, ld; };

struct StaticOrder {
    int nM, nN, nwg, G, c;
    __host__ __device__ void init(int M, int N, int G_, int c_) { nM = M / BM; nN = N / BM; nwg = nM * nN; G = G_; c = c_; }
    __host__ __device__ bool next(int i, Unit& u) const {
        const long L = (long)i * G + c; if (L >= nwg) return false;
        int wgid = (int)L; { const int q = nwg / NXCD, r = nwg % NXCD, xcd = wgid % NXCD, off = wgid / NXCD; wgid = (xcd < r ? xcd * (q + 1) : r * (q + 1) + (xcd - r) * q) + off; }
        const int nig = WGM * nN, gid = wgid / nig, fm = gid * WGM, gsz = (nM - fm) < WGM ? (nM - fm) : WGM;
        u.pm = fm + ((wgid % nig) % gsz); u.pn = (wgid % nig) / gsz; u.k0 = 0; return true;
    }
    __device__ __forceinline__ void a_ready(const Unit&) const {}
    __device__ __forceinline__ void done(const Unit&) const {}
};

__device__ __forceinline__ unsigned cvt_pk_bf16(float lo, float hi) { unsigned r; asm volatile("v_cvt_pk_bf16_f32 %0, %1, %2" : "=v"(r) : "v"(lo), "v"(hi)); return r; }
typedef float f32x2 __attribute__((ext_vector_type(2)));
struct EpiBf16 {
    static constexpr bool PERM = true, AFTER_DRAIN = false;
    bf16_t* O; int ldc;
    __device__ __forceinline__ void operator()(const f32x4 (&acc)[2][2][4][2], const Unit& u, int wr, int wc, int fr, int fq) const {
        const int row0 = u.pm * BM + wr * 64 + fr; const int col0 = u.pn * BM + wc * 32 + 8 * fq;
#pragma unroll
        for (int ai = 0; ai < 2; ++ai)
#pragma unroll
            for (int m = 0; m < 4; ++m) { bf16_t* rowp = O + (size_t)(row0 + ai * HALF + m * 16) * ldc + col0;
#pragma unroll
                for (int bj = 0; bj < 2; ++bj) { const f32x4 v0 = acc[ai][bj][m][0], v1 = acc[ai][bj][m][1];
                    u32x4 w; w.x = cvt_pk_bf16(v0[0], v0[1]); w.y = cvt_pk_bf16(v0[2], v0[3]); w.z = cvt_pk_bf16(v1[0], v1[1]); w.w = cvt_pk_bf16(v1[2], v1[3]);
                    *(u32x4*)(rowp + bj * HALF) = w; } }
    }
};
__device__ __forceinline__ float silu_f(float g) { return g * __builtin_amdgcn_rcpf(1.0f + __expf(-g)); }
struct EpiSwiGLU {
    static constexpr bool PERM = true, AFTER_DRAIN = false;
    bf16_t* O; int ldc;
    __device__ __forceinline__ void operator()(const f32x4 (&acc)[2][2][4][2], const Unit& u, int wr, int wc, int fr, int fq) const {
        const int row0 = u.pm * BM + wr * 64 + fr; const int col0 = u.pn * HALF + wc * 32 + 8 * fq;
#pragma unroll
        for (int ai = 0; ai < 2; ++ai)
#pragma unroll
            for (int m = 0; m < 4; ++m) { bf16_t* rowp = O + (size_t)(row0 + ai * HALF + m * 16) * ldc + col0;
                const f32x4 g0 = acc[ai][0][m][0], g1 = acc[ai][0][m][1], u0 = acc[ai][1][m][0], u1 = acc[ai][1][m][1];
                u32x4 w;
                w.x = cvt_pk_bf16(silu_f(g0[0]) * u0[0], silu_f(g0[1]) * u0[1]); w.y = cvt_pk_bf16(silu_f(g0[2]) * u0[2], silu_f(g0[3]) * u0[3]);
                w.z = cvt_pk_bf16(silu_f(g1[0]) * u1[0], silu_f(g1[1]) * u1[1]); w.w = cvt_pk_bf16(silu_f(g1[2]) * u1[2], silu_f(g1[3]) * u1[3]);
                *(u32x4*)rowp = w; }
    }
};
struct EpiF32 {
    static constexpr bool PERM = false, AFTER_DRAIN = false;
    float* O; int ldc;
    __device__ __forceinline__ void operator()(const f32x4 (&acc)[2][2][4][2], const Unit& u, int wr, int wc, int fr, int fq) const {
        const int row0 = u.pm * BM + wr * 64 + fr; const int col0 = u.pn * BM + wc * 32 + 4 * fq;
#pragma unroll
        for (int ai = 0; ai < 2; ++ai)
#pragma unroll
            for (int m = 0; m < 4; ++m) { float* rowp = O + (size_t)(row0 + ai * HALF + m * 16) * ldc + col0;
#pragma unroll
                for (int bj = 0; bj < 2; ++bj)
#pragma unroll
                    for (int n = 0; n < 2; ++n) *(f32x4*)(rowp + bj * HALF + n * 16) = acc[ai][bj][m][n]; }
    }
};
struct TailOrder {
    int pm, nN, nunits, kc, c;
    __device__ bool next(int i, Unit& u) const { if (i != 0 || c >= nunits) return false; u.pm = pm; u.pn = c % nN; u.k0 = (c / nN) * kc; return true; }
    __device__ __forceinline__ void a_ready(const Unit&) const {}
    __device__ __forceinline__ void done(const Unit&) const {}
};
struct EpiAtomicF32 {
    static constexpr bool PERM = false, AFTER_DRAIN = false;
    float* O; int ldc;
    __device__ __forceinline__ void operator()(const f32x4 (&acc)[2][2][4][2], const Unit& u, int wr, int wc, int fr, int fq) const {
        const int row0 = u.pm * BM + wr * 64 + fr; const int col0 = u.pn * BM + wc * 32 + 4 * fq;
#pragma unroll
        for (int m = 0; m < 4; ++m) { float* rowp = O + (size_t)(row0 + m * 16) * ldc + col0;
#pragma unroll
            for (int bj = 0; bj < 2; ++bj)
#pragma unroll
                for (int n = 0; n < 2; ++n)
#pragma unroll
                    for (int e = 0; e < 4; ++e) __hip_atomic_fetch_add(rowp + bj * HALF + n * 16 + e, acc[0][bj][m][n][e], __ATOMIC_RELAXED, __HIP_MEMORY_SCOPE_AGENT); }
    }
};
template <class Epi, class Sched, bool ALIGN_EPI = false, bool SP2 = false>
__device__ __forceinline__ void gemm_phase(PG8_LAS unsigned char* lds, const Gemm g, const Sched& S, const Epi& E) {
    const int tid = threadIdx.x, wid = __builtin_amdgcn_readfirstlane(tid >> 6), lane = tid & 63, wr = wid >> 2, wc = wid & 3, fr = lane & 15, fq = lane >> 4;
    const int K = g.ld, nt = g.K / BK;
    unsigned voffA[2], voffB[2];
#pragma unroll
    for (int i = 0; i < 2; ++i) { int R, C; stage_rc(tid * 16 + i * 8192, R, C); const int Rb = Epi::PERM ? ((R & ~31) + perm32(R & 31)) : R;
        voffA[i] = (unsigned)(R * K + C) * 2u; voffB[i] = (unsigned)(Rb * K + C) * 2u; }
    const size_t kstep = (size_t)(BK * 2);
    const size_t hstep = (size_t)HALF * K * 2;
    const size_t tstep = 2 * hstep;
    const unsigned ldsw = (unsigned)wid * 1024u;
    const int aoff = lds_byte(wr * 64 + fr, fq * 8), boff = lds_byte(wc * 32 + fr, fq * 8);
#define PG8_SA(b, h) (((b) * 2 + (h)) * HTB)
#define PG8_SB(b, h) ((4 + (b) * 2 + (h)) * HTB)
#define PG8_STAGE(bufoff, gbase, voff) do { _Pragma("unroll") for (int _i = 0; _i < 2; ++_i) \
        __builtin_amdgcn_global_load_lds((const unsigned*)((const char*)(gbase) + (voff)[_i]), (PG8_LAS unsigned*)(lds + (bufoff) + ldsw + _i * 8192), 16, 0, 0); } while (0)
#define PG8_LDA(dst, b, h) do { _Pragma("unroll") for (int m = 0; m < 4; ++m) _Pragma("unroll") for (int k = 0; k < 2; ++k) dst[m][k] = *(const PG8_LAS bf16x8*)(lds + PG8_SA(b, h) + aoff + m * 2048 + k * 1024); } while (0)
#define PG8_LDB(dst, b, h) do { _Pragma("unroll") for (int n = 0; n < 2; ++n) _Pragma("unroll") for (int k = 0; k < 2; ++k) dst[n][k] = *(const PG8_LAS bf16x8*)(lds + PG8_SB(b, h) + boff + n * 2048 + k * 1024); } while (0)
#define PG8_MMA(ai, bj, At, Bt) do { __builtin_amdgcn_s_setprio(1); _Pragma("unroll") for (int m = 0; m < 4; ++m) _Pragma("unroll") for (int n = 0; n < 2; ++n) _Pragma("unroll") for (int k = 0; k < 2; ++k) \
        acc[ai][bj][m][n] = __builtin_amdgcn_mfma_f32_16x16x32_bf16(Bt[n][k], At[m][k], acc[ai][bj][m][n], 0, 0, 0); __builtin_amdgcn_s_setprio(0); } while (0)
#define PG8_WAIT_V(n) asm volatile("s_waitcnt vmcnt(" #n ")" ::: "memory")
#define PG8_WAIT_L(n) asm volatile("s_waitcnt lgkmcnt(" #n ")" ::: "memory")
#define PG8_BAR __builtin_amdgcn_s_barrier()
#define PG8_SCHED __builtin_amdgcn_sched_barrier(0)
    Unit cur, nxt; int ui = 0;
    if (!S.next(0, cur)) return;
    f32x4 acc[2][2][4][2];
#pragma unroll
    for (int a = 0; a < 2; ++a)
#pragma unroll
        for (int b = 0; b < 2; ++b)
#pragma unroll
            for (int m = 0; m < 4; ++m)
#pragma unroll
                for (int n = 0; n < 2; ++n) acc[a][b][m][n] = (f32x4){0.f, 0.f, 0.f, 0.f};
    bf16x8 At[4][2], B0[2][2], B1[2][2];
    const char* cA = (const char*)g.A + (size_t)cur.pm * tstep + (size_t)cur.k0 * 2; const char* cB = (const char*)g.Bt + (size_t)cur.pn * tstep + (size_t)cur.k0 * 2;
    S.a_ready(cur);
    if constexpr (SP2) {
        PG8_STAGE(PG8_SB(0, 0), cB, voffB); PG8_STAGE(PG8_SB(0, 1), cB + hstep, voffB); PG8_STAGE(PG8_SA(0, 0), cA, voffA); PG8_STAGE(PG8_SA(0, 1), cA + hstep, voffA);
        if (wr == 1) PG8_BAR;
        PG8_WAIT_V(2); PG8_BAR;
        PG8_STAGE(PG8_SB(1, 0), cB + kstep, voffB); PG8_STAGE(PG8_SA(1, 0), cA + kstep, voffA); PG8_STAGE(PG8_SB(1, 1), cB + hstep + kstep, voffB);
        PG8_WAIT_V(6); PG8_BAR;
    } else {
        PG8_STAGE(PG8_SB(0, 0), cB, voffB); PG8_STAGE(PG8_SA(0, 0), cA, voffA); PG8_STAGE(PG8_SB(0, 1), cB + hstep, voffB); PG8_STAGE(PG8_SA(0, 1), cA + hstep, voffA);
        if (wr == 1) PG8_BAR;
        PG8_WAIT_V(4); PG8_BAR;
        PG8_STAGE(PG8_SB(1, 0), cB + kstep, voffB); PG8_STAGE(PG8_SA(1, 0), cA + kstep, voffA); PG8_STAGE(PG8_SB(1, 1), cB + hstep + kstep, voffB);
        PG8_WAIT_V(6); PG8_BAR;
    }
    for (;;) {
        const bool has_next = S.next(ui + 1, nxt);
        const char* nA = has_next ? (const char*)g.A + (size_t)nxt.pm * tstep + (size_t)nxt.k0 * 2 : cA; const char* nB = has_next ? (const char*)g.Bt + (size_t)nxt.pn * tstep + (size_t)nxt.k0 * 2 : cB;
        for (int t = 0; t < nt; t += 2) {
            const bool last = (t == nt - 2);
            const char* a1 = cA + (size_t)(t + 1) * kstep;
            const char* a2 = last ? nA : cA + (size_t)(t + 2) * kstep; const char* b2 = last ? nB : cB + (size_t)(t + 2) * kstep;
            const char* a3 = a2 + kstep; const char* b3 = b2 + kstep;
            if (last && has_next) S.a_ready(nxt);
            if constexpr (SP2) {
            PG8_LDB(B0, 0, 0); PG8_LDB(B1, 0, 1); PG8_SCHED; PG8_LDA(At, 0, 0); PG8_STAGE(PG8_SA(1, 1), a1 + hstep, voffA);
            PG8_WAIT_V(8); PG8_WAIT_L(0); PG8_BAR; PG8_MMA(0, 0, At, B0); PG8_MMA(0, 1, At, B1); PG8_BAR; PG8_SCHED;
            PG8_LDA(At, 0, 1); PG8_STAGE(PG8_SB(0, 0), b2, voffB); PG8_STAGE(PG8_SB(0, 1), b2 + hstep, voffB); PG8_STAGE(PG8_SA(0, 0), a2, voffA);
            PG8_WAIT_V(8); PG8_WAIT_L(0); PG8_BAR; PG8_MMA(1, 0, At, B0); PG8_MMA(1, 1, At, B1); PG8_BAR; PG8_SCHED;
            PG8_LDB(B0, 1, 0); PG8_LDB(B1, 1, 1); PG8_SCHED; PG8_LDA(At, 1, 0); PG8_STAGE(PG8_SA(0, 1), a2 + hstep, voffA);
            PG8_WAIT_V(8); PG8_WAIT_L(0); PG8_BAR; PG8_MMA(0, 0, At, B0); PG8_MMA(0, 1, At, B1); PG8_BAR; PG8_SCHED;
            PG8_LDA(At, 1, 1); PG8_STAGE(PG8_SB(1, 0), b3, voffB); PG8_STAGE(PG8_SB(1, 1), b3 + hstep, voffB); PG8_STAGE(PG8_SA(1, 0), a3, voffA);
            PG8_WAIT_V(8); PG8_WAIT_L(0); PG8_BAR; PG8_MMA(1, 0, At, B0); PG8_MMA(1, 1, At, B1); PG8_BAR; PG8_SCHED;
            } else {
            PG8_LDB(B0, 0, 0); PG8_SCHED; PG8_LDA(At, 0, 0); PG8_STAGE(PG8_SA(1, 1), a1 + hstep, voffA);
            PG8_WAIT_L(8); PG8_BAR; PG8_WAIT_L(0); PG8_MMA(0, 0, At, B0); PG8_BAR; PG8_SCHED;
            PG8_LDB(B1, 0, 1); PG8_STAGE(PG8_SB(0, 0), b2, voffB);
            PG8_BAR; PG8_WAIT_L(0); PG8_MMA(0, 1, At, B1); PG8_BAR;
            PG8_LDA(At, 0, 1); PG8_STAGE(PG8_SA(0, 0), a2, voffA);
            PG8_BAR; PG8_WAIT_L(0); PG8_MMA(1, 0, At, B0); PG8_BAR; PG8_SCHED;
            PG8_STAGE(PG8_SB(0, 1), b2 + hstep, voffB);
            PG8_WAIT_V(6); PG8_BAR; PG8_MMA(1, 1, At, B1); PG8_BAR;
            PG8_LDB(B0, 1, 0); PG8_SCHED; PG8_LDA(At, 1, 0); PG8_STAGE(PG8_SA(0, 1), a2 + hstep, voffA);
            PG8_WAIT_L(8); PG8_BAR; PG8_WAIT_L(0); PG8_MMA(0, 0, At, B0); PG8_BAR; PG8_SCHED;
            PG8_LDB(B1, 1, 1); PG8_STAGE(PG8_SB(1, 0), b3, voffB);
            PG8_BAR; PG8_WAIT_L(0); PG8_MMA(0, 1, At, B1); PG8_BAR;
            PG8_LDA(At, 1, 1); PG8_STAGE(PG8_SA(1, 0), a3, voffA);
            PG8_BAR; PG8_WAIT_L(0); PG8_MMA(1, 0, At, B0); PG8_BAR; PG8_SCHED;
            PG8_STAGE(PG8_SB(1, 1), b3 + hstep, voffB);
            PG8_WAIT_V(6); PG8_BAR; PG8_MMA(1, 1, At, B1); PG8_BAR;
            }
        }
        if constexpr (ALIGN_EPI) { if (wr == 0) PG8_BAR; }
        if constexpr (!Epi::AFTER_DRAIN) { E(acc, cur, wr, wc, fr, fq); S.done(cur); }
        if (!has_next) break;
#pragma unroll
        for (int a = 0; a < 2; ++a)
#pragma unroll
            for (int b = 0; b < 2; ++b)
#pragma unroll
                for (int m = 0; m < 4; ++m)
#pragma unroll
                    for (int n = 0; n < 2; ++n) acc[a][b][m][n] = (f32x4){0.f, 0.f, 0.f, 0.f};
        cur = nxt; cA = nA; cB = nB; ++ui;
        if constexpr (ALIGN_EPI) { if (wr == 1) PG8_BAR; }
    }
    PG8_WAIT_V(0);
    if constexpr (!ALIGN_EPI) { if (wr == 0) PG8_BAR; }
    PG8_BAR;
    if constexpr (Epi::AFTER_DRAIN) { E.fused(acc, cur, wr, wc, fr, fq, lds, wid, lane); S.done(cur); }
#undef PG8_SA
#undef PG8_SB
#undef PG8_STAGE
#undef PG8_LDA
#undef PG8_LDB
#undef PG8_MMA
#undef PG8_WAIT_V
#undef PG8_WAIT_L
#undef PG8_BAR
#undef PG8_SCHED
}
}

constexpr int DM = 1024, SEQ = 4096, NBATCH = 4, MPROMPT = 16384, MSAMP = 128, MTOK = 16512, MPAD = 16640, DFF = 2816, NGU = 5632, NIN = 2816;
constexpr int C_Q = 0, C_K = 512, C_V = 640, C_HQ = 768, C_HF = 1280, C_HI = 1792, C_HG = 2304;
constexpr float EPS = 1e-6f;
constexpr float LOG2E = 1.4426950408889634f;
constexpr float PAST_POS = 8192.0f;
constexpr size_t O_WKP = (size_t)MTOK * DM, O_WVP = O_WKP + 65536, O_SP = O_WVP + 65536, O_WKS = O_SP + 131072, O_WVS = O_WKS + 2097152, O_SS = O_WVS + 2097152;
constexpr size_t MiB = 1u << 20;
constexpr size_t WS_WGU1 = 1 * MiB, WS_WDN1 = 12 * MiB, WS_WIN = 18 * MiB, WS_WOUT = 24 * MiB, WS_WGU2 = 26 * MiB, WS_WDN2 = 37 * MiB;
constexpr size_t WS_LB = 43 * MiB;
constexpr size_t WS_XN = 44 * MiB;
constexpr size_t WS_ACT = 77 * MiB;
constexpr size_t WS_Y = 167 * MiB;
constexpr size_t WS_QE = WS_Y, WS_KE = WS_Y + 16 * MiB, WS_VT = WS_Y + 32 * MiB, WS_UT = WS_Y + 48 * MiB, WS_D = WS_LB + 65536;
constexpr size_t WS_END = 232 * MiB;
static_assert(WS_XN + (size_t)MPAD * DM * 2 <= WS_ACT && WS_ACT + (size_t)MPAD * DFF * 2 <= WS_Y && WS_Y + (size_t)MPAD * DM * 4 <= WS_END, "ws map");

constexpr int LDS_BYTES = 148480;
constexpr int LDS_BARW = 147456;

#define GAS __attribute__((address_space(1)))
#define LAS __attribute__((address_space(3)))
typedef unsigned short bf16;
typedef unsigned v4u __attribute__((ext_vector_type(4)));
typedef float f32x4 __attribute__((ext_vector_type(4)));
typedef short bf16x8 __attribute__((ext_vector_type(8)));
#define LDS_WAIT() asm volatile("s_waitcnt lgkmcnt(0)" ::: "memory")
#define DI __device__ __forceinline__

DI unsigned f2bf(float f) { unsigned u = __builtin_bit_cast(unsigned, f); return (u + 0x7fffu + ((u >> 16) & 1u)) >> 16; }
DI unsigned pk2(float lo, float hi) { return f2bf(lo) | (f2bf(hi) << 16); }
DI float bf2f(unsigned short h) { return __uint_as_float(((unsigned)h) << 16); }
DI float wave_sum(float v) {
#pragma unroll
    for (int o = 1; o < 64; o <<= 1) v += __shfl_xor(v, o);
    return v;
}
DI float wave_max(float v) {
#pragma unroll
    for (int o = 1; o < 64; o <<= 1) v = fmaxf(v, __shfl_xor(v, o));
    return v;
}
DI float sigmoid_f(float x) { return __builtin_amdgcn_rcpf(1.0f + __expf(-x)); }
DI float silu2_f(float x) { return x * sigmoid_f(x); }
DI void rope_cs(float pos, int i, float& c, float& s) {
    const float inv = __builtin_amdgcn_exp2f(-(float)i * 2.3664460711655217f);
    float rev = (pos * inv) * 0.15915494309189535f;
    rev = rev - floorf(rev);
    s = __builtin_amdgcn_sinf(rev); c = __builtin_amdgcn_cosf(rev);
}
DI void unpack8(const v4u raw, float (&f)[8]) {
#pragma unroll
    for (int i = 0; i < 4; ++i) { f[2 * i] = __uint_as_float(raw[i] << 16); f[2 * i + 1] = __uint_as_float(raw[i] & 0xffff0000u); }
}
DI v4u pack8(const float (&f)[8]) { v4u o; o.x = pk2(f[0], f[1]); o.y = pk2(f[2], f[3]); o.z = pk2(f[4], f[5]); o.w = pk2(f[6], f[7]); return o; }
DI float rope_elem(const bf16* hp, int d, float pos) {
    const int i = d & 7; float c, s; rope_cs(pos, i, c, s);
    const float x1 = bf2f(hp[i]), x2 = bf2f(hp[i + 8]);
    return d < 8 ? x1 * c - x2 * s : x2 * c + x1 * s;
}

template <int MODE> DI void tr_item(const float* W, int K, int N, const float* gain, bf16* WT, LAS float* scr, int item, int lane) {
    const int nblk = N / 32, kb = item / nblk, nb = item % nblk, k0 = 64 * kb, n0 = 32 * nb;
#pragma unroll
    for (int i = 0; i < 32; ++i) { const int kk = 2 * i + (lane >> 5); float w = W[(size_t)(k0 + kk) * N + n0 + (lane & 31)]; if (gain) w *= gain[k0 + kk]; scr[kk * 33 + (lane & 31)] = w; }
    LDS_WAIT(); asm volatile("" ::: "memory");
    const int c = lane & 7;
#pragma unroll
    for (int j = 0; j < 4; ++j) { const int n = (lane >> 3) + 8 * j; const LAS float* s = scr + (8 * c) * 33 + n;
        v4u o; o.x = pk2(s[0 * 33], s[1 * 33]); o.y = pk2(s[2 * 33], s[3 * 33]); o.z = pk2(s[4 * 33], s[5 * 33]); o.w = pk2(s[6 * 33], s[7 * 33]);
        const int ns = n0 + n; int drow = ns;
        if (MODE == 1) drow = ns < DFF ? ((ns >> 7) * 256 + (ns & 127)) : (((ns - DFF) >> 7) * 256 + 128 + ((ns - DFF) & 127));
        *(v4u*)(WT + (size_t)drow * K + k0 + 8 * c) = o; }
    LDS_WAIT(); asm volatile("" ::: "memory");
}
DI void norm_row_to_bf16(const float* xrow, bf16* orow, int lane) {
    const f32x4* xr = (const f32x4*)xrow + lane;
    f32x4 v[4]; float s = 0.f;
#pragma unroll
    for (int j = 0; j < 4; ++j) { v[j] = xr[64 * j]; s += (v[j].x * v[j].x + v[j].y * v[j].y) + (v[j].z * v[j].z + v[j].w * v[j].w); }
    const float r = __builtin_amdgcn_rsqf(wave_sum(s) * (1.f / DM) + EPS);
    unsigned long long* o8 = (unsigned long long*)orow + lane;
#pragma unroll
    for (int j = 0; j < 4; ++j) o8[64 * j] = (unsigned long long)pk2(v[j].x * r, v[j].y * r) | ((unsigned long long)pk2(v[j].z * r, v[j].w * r) << 32);
}
DI void resid_row(const float* xrow, const float* yrow, const float* g, float coef, float* orow, bf16* xnrow, int lane, bool zero_y) {
    const f32x4* xr = (const f32x4*)xrow + lane; const f32x4* yr = (const f32x4*)yrow + lane; const f32x4* gr = (const f32x4*)g + lane;
    f32x4 xv[4], yv[4]; float s = 0.f;
#pragma unroll
    for (int j = 0; j < 4; ++j) { xv[j] = xr[64 * j]; yv[j] = yr[64 * j]; s += (yv[j].x * yv[j].x + yv[j].y * yv[j].y) + (yv[j].z * yv[j].z + yv[j].w * yv[j].w); }
    if (zero_y) {
#pragma unroll
        for (int j = 0; j < 4; ++j) ((f32x4*)yrow + lane)[64 * j] = (f32x4){0.f, 0.f, 0.f, 0.f}; }
    const float ry = __builtin_amdgcn_rsqf(wave_sum(s) * (1.f / DM) + EPS) * coef;
    float s2 = 0.f;
#pragma unroll
    for (int j = 0; j < 4; ++j) { const f32x4 gv = gr[64 * j]; xv[j] = xv[j] + (yv[j] * ry) * gv; s2 += (xv[j].x * xv[j].x + xv[j].y * xv[j].y) + (xv[j].z * xv[j].z + xv[j].w * xv[j].w); }
    f32x4* orp = (f32x4*)orow + lane;
#pragma unroll
    for (int j = 0; j < 4; ++j) orp[64 * j] = xv[j];
    if (xnrow) {
        const float r = __builtin_amdgcn_rsqf(wave_sum(s2) * (1.f / DM) + EPS);
        unsigned long long* o8 = (unsigned long long*)xnrow + lane;
#pragma unroll
        for (int j = 0; j < 4; ++j) o8[64 * j] = (unsigned long long)pk2(xv[j].x * r, xv[j].y * r) | ((unsigned long long)pk2(xv[j].z * r, xv[j].w * r) << 32);
    }
}

#define MFMA16(a, b, c) __builtin_amdgcn_mfma_f32_16x16x32_bf16((a), (b), (c), 0, 0, 0)

constexpr int AT_KS = 0, AT_KS_ROW = 144, AT_VT = 36864, AT_VT_ROW = 528, AT_PS = AT_VT + 64 * 528, AT_PS_WAVE = 16 * 528;
static_assert(AT_PS + 8 * AT_PS_WAVE <= LDS_BYTES, "attention LDS");
DI void attn_prompt_unit(LAS unsigned char* lds, const bf16* P, bf16* CAT, const float* sinks, int b, int nbk, int kvh, int tid, int lane, int wave) {
    {
        const int kj = tid >> 1, half = tid & 1; const int t = 128 * (nbk - 1) + kj;
        LAS unsigned char* krow = lds + AT_KS + kj * AT_KS_ROW + half * 64;
        LAS bf16* vt = (LAS bf16*)(lds + AT_VT);
        if (t < 0) {
            const v4u z = (v4u){0u, 0u, 0u, 0u};
#pragma unroll
            for (int c = 0; c < 4; ++c) *(LAS v4u*)(krow + 16 * c) = z;
#pragma unroll
            for (int i = 0; i < 32; ++i) vt[(32 * half + i) * (AT_VT_ROW / 2) + kj] = 0;
        } else {
            const bf16* prow = P + (size_t)(b * SEQ + t) * NIN;
            const v4u* kp = (const v4u*)(prow + C_K + 64 * kvh + 32 * half);
            v4u c0 = kp[0], c1 = kp[1], c2 = kp[2], c3 = kp[3];
            if (half == 0) {
                float x1[8], x2[8], o1[8], o2[8]; unpack8(c0, x1); unpack8(c1, x2);
#pragma unroll
                for (int i = 0; i < 8; ++i) { float c, s; rope_cs((float)t, i, c, s); o1[i] = x1[i] * c - x2[i] * s; o2[i] = x2[i] * c + x1[i] * s; }
                c0 = pack8(o1); c1 = pack8(o2);
            }
            *(LAS v4u*)(krow) = c0; *(LAS v4u*)(krow + 16) = c1; *(LAS v4u*)(krow + 32) = c2; *(LAS v4u*)(krow + 48) = c3;
            const v4u* vp = (const v4u*)(prow + C_V + 64 * kvh + 32 * half);
#pragma unroll
            for (int c = 0; c < 4; ++c) { const v4u raw = vp[c];
#pragma unroll
                for (int i = 0; i < 4; ++i) { vt[(32 * half + 8 * c + 2 * i) * (AT_VT_ROW / 2) + kj] = (bf16)(raw[i] & 0xffffu); vt[(32 * half + 8 * c + 2 * i + 1) * (AT_VT_ROW / 2) + kj] = (bf16)(raw[i] >> 16); } }
        }
    }
    __syncthreads();
    const int g = wave >> 1, qhalf = wave & 1, h = 4 * kvh + g, fr = lane & 15, fq = lane >> 4;
    const float sink2 = sinks[h] * LOG2E;
    LAS unsigned char* ps = lds + AT_PS + wave * AT_PS_WAVE;
#pragma unroll 1
    for (int sb = 0; sb < 4; ++sb) {
        const int q0 = 64 * qhalf + 16 * sb;
        bf16x8 qa[2];
        {
            const int qi = q0 + fr; const int t = 128 * nbk + qi;
            const bf16* qp = P + (size_t)(b * SEQ + t) * NIN + C_Q + 64 * h;
            v4u r0 = *(const v4u*)(qp + 8 * fq), r1 = *(const v4u*)(qp + 32 + 8 * fq);
            if (fq < 2) {
                const v4u other = *(const v4u*)(qp + 8 * (fq ^ 1));
                float a[8], o[8], x[8]; unpack8(r0, a); unpack8(other, o);
#pragma unroll
                for (int i = 0; i < 8; ++i) { float c, s; rope_cs((float)t, i, c, s); x[i] = fq == 0 ? a[i] * c - o[i] * s : a[i] * c + o[i] * s; }
                r0 = pack8(x);
            }
            qa[0] = __builtin_bit_cast(bf16x8, r0); qa[1] = __builtin_bit_cast(bf16x8, r1);
        }
        f32x4 sc[16];
#pragma unroll
        for (int n = 0; n < 16; ++n) {
            sc[n] = (f32x4){0.f, 0.f, 0.f, 0.f};
#pragma unroll
            for (int ks = 0; ks < 2; ++ks) { const bf16x8 kb = *(const LAS bf16x8*)(lds + AT_KS + (16 * n + fr) * AT_KS_ROW + (32 * ks + 8 * fq) * 2); sc[n] = MFMA16(qa[ks], kb, sc[n]); }
        }
        float mx[4], sm[4];
#pragma unroll
        for (int j = 0; j < 4; ++j) {
            const int qi = q0 + 4 * fq + j; float m = -1e30f;
#pragma unroll
            for (int n = 0; n < 16; ++n) { const int kj = 16 * n + fr; const bool valid = (kj > qi) && (kj <= qi + 128) && (nbk > 0 || kj >= 128);
                const float v = valid ? sc[n][j] * (0.125f * LOG2E) : -1e30f; sc[n][j] = v; m = fmaxf(m, v); }
            m = fmaxf(m, __shfl_xor(m, 1)); m = fmaxf(m, __shfl_xor(m, 2)); m = fmaxf(m, __shfl_xor(m, 4)); m = fmaxf(m, __shfl_xor(m, 8));
            m = fmaxf(m, sink2); mx[j] = m;
            float s = 0.f;
#pragma unroll
            for (int n = 0; n < 16; ++n) { const float p = __builtin_amdgcn_exp2f(sc[n][j] - m); sc[n][j] = p; s += p; }
            s += __shfl_xor(s, 1); s += __shfl_xor(s, 2); s += __shfl_xor(s, 4); s += __shfl_xor(s, 8);
            sm[j] = __builtin_amdgcn_rcpf(s + __builtin_amdgcn_exp2f(sink2 - m));
        }
#pragma unroll
        for (int n = 0; n < 16; ++n)
#pragma unroll
            for (int j = 0; j < 4; ++j) *(LAS bf16*)(ps + (4 * fq + j) * AT_VT_ROW + (16 * n + fr) * 2) = (bf16)f2bf(sc[n][j]);
        LDS_WAIT(); asm volatile("" ::: "memory");
        f32x4 o[4];
#pragma unroll
        for (int n = 0; n < 4; ++n) o[n] = (f32x4){0.f, 0.f, 0.f, 0.f};
#pragma unroll
        for (int ks = 0; ks < 8; ++ks) { const bf16x8 pa = *(const LAS bf16x8*)(ps + fr * AT_VT_ROW + (32 * ks + 8 * fq) * 2);
#pragma unroll
            for (int n = 0; n < 4; ++n) { const bf16x8 vb = *(const LAS bf16x8*)(lds + AT_VT + (16 * n + fr) * AT_VT_ROW + (32 * ks + 8 * fq) * 2); o[n] = MFMA16(pa, vb, o[n]); } }
        LDS_WAIT(); asm volatile("" ::: "memory");
#pragma unroll
        for (int j = 0; j < 4; ++j) { bf16* op = CAT + (size_t)(b * SEQ + 128 * nbk + q0 + 4 * fq + j) * DM + 64 * h + fr;
#pragma unroll
            for (int n = 0; n < 4; ++n) op[16 * n] = (bf16)f2bf(o[n][j] * sm[j]); }
    }
    __syncthreads();
}

constexpr int HG_ROW = 144, HG_WAVE_LDS = 18432;
DI void hgrn_gate_unit(LAS unsigned char* ldsw, const bf16* P, const float* lbv, bf16* QE, bf16* KE, bf16* VTg, bf16* UT, float* Dws, int b, int h, int c, int lane) {
    const int r0 = b * SEQ + 64 * c, unit = (b * 8 + h) * 64 + c, fr = lane & 15, fq = lane >> 4;
    const float lb = lbv[64 * h + lane];
    const bf16* pp = P + (size_t)r0 * NIN + 64 * h + lane;
    bf16* qep = QE + (size_t)r0 * 512 + 64 * h + lane; bf16* kep = KE + (size_t)r0 * 512 + 64 * h + lane;
    {
        unsigned w[64];
#pragma unroll
        for (int t = 0; t < 64; ++t) w[t] = pp[(size_t)t * NIN + C_HI];
#pragma unroll
        for (int s8 = 0; s8 < 8; ++s8) {
            const v4u o = (v4u){w[8 * s8] | (w[8 * s8 + 1] << 16), w[8 * s8 + 2] | (w[8 * s8 + 3] << 16), w[8 * s8 + 4] | (w[8 * s8 + 5] << 16), w[8 * s8 + 6] | (w[8 * s8 + 7] << 16)};
            *(LAS v4u*)(ldsw + 9216 + lane * HG_ROW + 16 * s8) = o;
            *(v4u*)(VTg + (size_t)unit * 4096 + lane * 64 + 8 * s8) = o; }
    }
    float ke[64]; float run = 0.f;
    {
        unsigned short hfr[64], hqr[64];
#pragma unroll
        for (int t = 0; t < 64; ++t) { hfr[t] = pp[(size_t)t * NIN + C_HF]; hqr[t] = pp[(size_t)t * NIN + C_HQ]; }
#pragma unroll
        for (int t = 0; t < 64; ++t) {
            const float hf = bf2f(hfr[t]), hq = bf2f(hqr[t]);
            const float f = lb + (1.0f - lb) * sigmoid_f(hf); run += __logf(f);
            qep[t * 512] = (bf16)f2bf(hq * 0.125f * __expf(run));
            const float k_ = (1.0f - f) * __expf(-run); kep[t * 512] = (bf16)f2bf(k_); ke[t] = k_;
        }
    }
    const float D = __expf(run);
    Dws[(size_t)unit * 64 + lane] = D;
#pragma unroll
    for (int s8 = 0; s8 < 8; ++s8) { float kd[8];
#pragma unroll
        for (int i = 0; i < 8; ++i) kd[i] = ke[8 * s8 + i] * D;
        *(LAS v4u*)(ldsw + lane * HG_ROW + 16 * s8) = pack8(kd); }
    LDS_WAIT(); asm volatile("" ::: "memory");
    bf16x8 vb[4][2];
#pragma unroll
    for (int nb = 0; nb < 4; ++nb)
#pragma unroll
        for (int ks = 0; ks < 2; ++ks) vb[nb][ks] = *(const LAS bf16x8*)(ldsw + 9216 + (16 * nb + fr) * HG_ROW + (32 * ks + 8 * fq) * 2);
#pragma unroll
    for (int mb = 0; mb < 4; ++mb) {
        bf16x8 ka[2];
#pragma unroll
        for (int ks = 0; ks < 2; ++ks) ka[ks] = *(const LAS bf16x8*)(ldsw + (16 * mb + fr) * HG_ROW + (32 * ks + 8 * fq) * 2);
#pragma unroll
        for (int nb = 0; nb < 4; ++nb) { f32x4 acc = (f32x4){0.f, 0.f, 0.f, 0.f};
            acc = MFMA16(ka[0], vb[nb][0], acc); acc = MFMA16(ka[1], vb[nb][1], acc);
            uint2 o; o.x = pk2(acc[0], acc[1]); o.y = pk2(acc[2], acc[3]);
            *(uint2*)(UT + (size_t)unit * 4096 + (16 * nb + fr) * 64 + 16 * mb + 4 * fq) = o; }
    }
    LDS_WAIT(); asm volatile("" ::: "memory");
}
DI void hgrn_out_unit(const bf16* P, const bf16* QE, const bf16* KE, const bf16* VTg, const bf16* SPT, const float* outg, bf16* CAT, int b, int h, int c, int lane) {
    const int r0 = b * SEQ + 64 * c, unit = (b * 8 + h) * 64 + c, fr = lane & 15, fq = lane >> 4;
    const bf16* qep = QE + (size_t)r0 * 512 + 64 * h; const bf16* kep = KE + (size_t)r0 * 512 + 64 * h;
    const bf16* vtp = VTg + (size_t)unit * 4096; const bf16* spp = SPT + (size_t)unit * 4096;
    bf16x8 spa[4][2], vta[4][2];
#pragma unroll
    for (int mb = 0; mb < 4; ++mb)
#pragma unroll
        for (int ks = 0; ks < 2; ++ks) {
            spa[mb][ks] = *(const bf16x8*)(spp + (16 * mb + fr) * 64 + 32 * ks + 8 * fq);
            const uint2 lo = *(const uint2*)(vtp + (16 * mb + fr) * 64 + 32 * ks + 4 * fq), hi = *(const uint2*)(vtp + (16 * mb + fr) * 64 + 32 * ks + 16 + 4 * fq);
            vta[mb][ks] = __builtin_bit_cast(bf16x8, ((v4u){lo.x, lo.y, hi.x, hi.y}));
        }
    f32x4 og[4];
#pragma unroll
    for (int mb = 0; mb < 4; ++mb) og[mb] = *(const f32x4*)(outg + 16 * mb + 4 * fq);
    bf16x8 qbs[4][2], kas[4][2];
#pragma unroll
    for (int nb = 0; nb < 4; ++nb)
#pragma unroll
        for (int ks = 0; ks < 2; ++ks) { qbs[nb][ks] = *(const bf16x8*)(qep + (size_t)(16 * nb + fr) * 512 + 32 * ks + 8 * fq); kas[nb][ks] = *(const bf16x8*)(kep + (size_t)(16 * nb + fr) * 512 + 32 * ks + 8 * fq); }
#pragma unroll
    for (int nb = 0; nb < 4; ++nb) {
        uint2 hgs[4];
#pragma unroll
        for (int mb = 0; mb < 4; ++mb) hgs[mb] = *(const uint2*)(P + (size_t)(r0 + 16 * nb + fr) * NIN + C_HG + 64 * h + 16 * mb + 4 * fq);
        f32x4 at[4];
#pragma unroll
        for (int sb = 0; sb < 4; ++sb) { at[sb] = (f32x4){0.f, 0.f, 0.f, 0.f};
            if (sb <= nb) {
                at[sb] = MFMA16(kas[sb][0], qbs[nb][0], at[sb]); at[sb] = MFMA16(kas[sb][1], qbs[nb][1], at[sb]);
                if (sb == nb) {
#pragma unroll
                    for (int j = 0; j < 4; ++j) if (4 * fq + j > fr) at[sb][j] = 0.f;
                }
            } }
        bf16x8 bat[2];
#pragma unroll
        for (int p = 0; p < 2; ++p) bat[p] = __builtin_bit_cast(bf16x8, ((v4u){pk2(at[2 * p][0], at[2 * p][1]), pk2(at[2 * p][2], at[2 * p][3]), pk2(at[2 * p + 1][0], at[2 * p + 1][1]), pk2(at[2 * p + 1][2], at[2 * p + 1][3])}));
        f32x4 o[4]; float ss = 0.f;
#pragma unroll
        for (int mb = 0; mb < 4; ++mb) { o[mb] = (f32x4){0.f, 0.f, 0.f, 0.f};
            o[mb] = MFMA16(spa[mb][0], qbs[nb][0], o[mb]); o[mb] = MFMA16(spa[mb][1], qbs[nb][1], o[mb]);
            o[mb] = MFMA16(vta[mb][0], bat[0], o[mb]); if (nb >= 2) o[mb] = MFMA16(vta[mb][1], bat[1], o[mb]);
            ss += (o[mb][0] * o[mb][0] + o[mb][1] * o[mb][1]) + (o[mb][2] * o[mb][2] + o[mb][3] * o[mb][3]); }
        ss += __shfl_xor(ss, 16); ss += __shfl_xor(ss, 32);
        const float r = __builtin_amdgcn_rsqf(ss * (1.0f / 64.0f) + EPS);
        const size_t row = (size_t)(r0 + 16 * nb + fr);
#pragma unroll
        for (int mb = 0; mb < 4; ++mb) {
            const uint2 hgr = hgs[mb];
            const float g0 = __uint_as_float(hgr.x << 16), g1 = __uint_as_float(hgr.x & 0xffff0000u), g2 = __uint_as_float(hgr.y << 16), g3 = __uint_as_float(hgr.y & 0xffff0000u);
            uint2 w; w.x = pk2(o[mb][0] * r * og[mb][0] * silu2_f(g0), o[mb][1] * r * og[mb][1] * silu2_f(g1)); w.y = pk2(o[mb][2] * r * og[mb][2] * silu2_f(g2), o[mb][3] * r * og[mb][3] * silu2_f(g3));
            *(uint2*)(CAT + row * DM + 512 + 64 * h + 16 * mb + 4 * fq) = w; }
    }
}

constexpr int SA_KL = 0, SA_VL = 33280, SA_QL = 66048, SA_SL = 67072, SA_RL = 69120;
DI void attn_sample_unit(LAS unsigned char* lds, const bf16* P, const float* cache_k, const float* cache_v, const float* sinks, float* out, bf16* CAT, int b, int kvh, int tid, int lane, int wave) {
    LAS float* KL = (LAS float*)(lds + SA_KL); LAS float* VL = (LAS float*)(lds + SA_VL); LAS float* QL = (LAS float*)(lds + SA_QL); LAS float* SL = (LAS float*)(lds + SA_SL); LAS float* RL = (LAS float*)(lds + SA_RL);
    const bf16* prow = P + (size_t)(MPROMPT + b) * NIN;
#pragma unroll 4
    for (int i = 0; i < 16; ++i) { const int idx = tid + 512 * i, key = idx >> 6, d = idx & 63; float kv, vv;
        if (key < 127) { const size_t src = ((size_t)(b * 128 + key + 1) * 2 + kvh) * 64 + d; kv = cache_k[src]; vv = cache_v[src]; }
        else { const bf16* hp = prow + C_K + 64 * kvh; kv = d < 16 ? rope_elem(hp, d, PAST_POS) : bf2f(hp[d]); vv = bf2f(prow[C_V + 64 * kvh + d]); }
        KL[key * 65 + d] = kv; VL[key * 64 + d] = vv;
        const size_t dst = ((size_t)(b * 128 + key) * 2 + kvh) * 64 + d; out[O_WKS + dst] = kv; out[O_WVS + dst] = vv; }
    if (tid < 256) { const int g = tid >> 6, d = tid & 63; const bf16* hp = prow + C_Q + 64 * (4 * kvh + g);
        const float q = d < 16 ? rope_elem(hp, d, PAST_POS) : bf2f(hp[d]); QL[g * 64 + d] = q * (0.125f * LOG2E); }
    __syncthreads();
    { const int g = tid >> 7, j = tid & 127; float s = 0.f;
#pragma unroll 16
      for (int d = 0; d < 64; ++d) s += QL[g * 64 + d] * KL[j * 65 + d];
      SL[g * 128 + j] = s; }
    __syncthreads();
    if (wave < 4) { const int g = wave; const float sink2 = sinks[4 * kvh + g] * LOG2E; const float s0 = SL[g * 128 + lane], s1 = SL[g * 128 + 64 + lane];
        const float m = fmaxf(wave_max(fmaxf(s0, s1)), sink2); const float p0 = __builtin_amdgcn_exp2f(s0 - m), p1 = __builtin_amdgcn_exp2f(s1 - m);
        const float sum = wave_sum(p0 + p1) + __builtin_amdgcn_exp2f(sink2 - m); SL[g * 128 + lane] = p0; SL[g * 128 + 64 + lane] = p1; if (lane == 0) RL[g] = 1.0f / sum; }
    __syncthreads();
    if (tid < 256) { const int g = tid >> 6, d = tid & 63; float o = 0.f;
#pragma unroll 16
        for (int j = 0; j < 128; ++j) o += SL[g * 128 + j] * VL[j * 64 + d];
        CAT[(size_t)(MPROMPT + b) * DM + 64 * (4 * kvh + g) + d] = (bf16)f2bf(o * RL[g]); }
    __syncthreads();
}
DI void hgrn_sample_unit(const bf16* P, const float* lbv, const float* state, const float* outg, float* out, bf16* CAT, int b, int h, int lane) {
    const bf16* prow = P + (size_t)(MPROMPT + b) * NIN + 64 * h + lane;
    const float lb = lbv[64 * h + lane];
    const float q = bf2f(prow[C_HQ]) * 0.125f, f = lb + (1.0f - lb) * sigmoid_f(bf2f(prow[C_HF])), kk = 1.0f - f, v = bf2f(prow[C_HI]), hg = bf2f(prow[C_HG]);
    const float* S = state + (size_t)(b * 8 + h) * 4096 + lane; float* So = out + O_SS + (size_t)(b * 8 + h) * 4096 + lane;
    float o = 0.f; float sv[64];
#pragma unroll
    for (int k = 0; k < 64; ++k) sv[k] = S[k * 64];
#pragma unroll
    for (int k = 0; k < 64; ++k) { const float fk = __shfl(f, k), kkk = __shfl(kk, k), qk = __shfl(q, k); const float sn = fk * sv[k] + kkk * v; So[k * 64] = sn; o += qk * sn; }
    const float r = __builtin_amdgcn_rsqf(wave_sum(o * o) * (1.0f / 64.0f) + EPS);
    CAT[(size_t)(MPROMPT + b) * DM + 512 + 64 * h + lane] = (bf16)f2bf(o * r * outg[lane] * silu2_f(hg));
}

#define XB_TMO      128
#define XB_XCNT(j)  (256  + 64 * (j))
#define XB_XSUB(j)  (1280 + 64 * (j))
#define XB_XGEN(j)  (2304 + 64 * (j))
#define XB_TOP      3328
#define XB_TOPGEN   3392
#define XCD_BAR_WORDS 3456
#define XB_SPIN_CAP (1u << 18)

__device__ __forceinline__ unsigned xb_ld(unsigned* p)              { return __hip_atomic_load(p, __ATOMIC_RELAXED, __HIP_MEMORY_SCOPE_AGENT); }
__device__ __forceinline__ unsigned xb_add(unsigned* p, unsigned v) { return __hip_atomic_fetch_add(p, v, __ATOMIC_RELAXED, __HIP_MEMORY_SCOPE_AGENT); }
__device__ __forceinline__ unsigned xb_xcc_id() { return (unsigned)__builtin_amdgcn_s_getreg((3 << 11) | 20) & 0xFu; }
#define XB_SPIN(cond, bar) do { unsigned _sp = 0; while (cond) { __builtin_amdgcn_s_sleep(1); \
    if ((++_sp & 255u) == 0u) { if (xb_ld(&(bar)[XB_TMO])) break; if (_sp > XB_SPIN_CAP) { atomicAdd(&(bar)[XB_TMO], 1u); break; } } } } while (0)

struct XcdBarrier {
    unsigned* bar; unsigned x;
    volatile LAS unsigned* st;
};

__device__ __forceinline__ XcdBarrier xcd_barrier_post(unsigned* bar, volatile LAS unsigned* st) {
    XcdBarrier b; b.bar = bar; b.x = xb_xcc_id(); b.st = st;
    if (threadIdx.x == 0) (void)xb_add(&bar[XB_XCNT(b.x)], 1u);
    return b;
}
__device__ __forceinline__ void xcd_barrier_complete(unsigned* bar, unsigned x, unsigned& nloc, unsigned& nx) {
    const unsigned G = gridDim.x * gridDim.y * gridDim.z;
    unsigned sum, cnt, mine, sp = 0u;
    for (;;) {
        sum = 0u; cnt = 0u; mine = 0u;
#pragma unroll
        for (unsigned j = 0; j < 16; ++j) { const unsigned c = xb_ld(&bar[XB_XCNT(j)]); sum += c; cnt += (c > 0u) ? 1u : 0u; mine = (j == x) ? c : mine; }
        if (sum == G) break;
        __builtin_amdgcn_s_sleep(1);
        if ((++sp & 255u) == 0u) { if (xb_ld(&bar[XB_TMO])) break; if (sp > XB_SPIN_CAP) { atomicAdd(&bar[XB_TMO], 1u); break; } }
    }
    nloc = mine > 0u ? mine : 1u; nx = cnt > 0u ? cnt : 1u;
}

__device__ __forceinline__ void xcd_barrier(const XcdBarrier& b) {
    asm volatile("s_waitcnt vmcnt(0)" ::: "memory");
    __syncthreads();
    if (threadIdx.x == 0) {
        unsigned* bar = b.bar;
        __builtin_amdgcn_s_waitcnt(0);
        unsigned nloc = b.st[0], nx = b.st[1];
        if (nloc == 0u) { xcd_barrier_complete(bar, b.x, nloc, nx); b.st[0] = nloc; b.st[1] = nx; }
        const unsigned old = xb_add(&bar[XB_XSUB(b.x)], 1u);
        const unsigned gen = old / nloc;
        if (old + 1u == (gen + 1u) * nloc) {
            __builtin_amdgcn_fence(__ATOMIC_RELEASE, "agent");
            asm volatile("s_waitcnt vmcnt(0)" ::: "memory");
            const unsigned og = xb_add(&bar[XB_TOP], 1u);
            const unsigned tg = og / nx;
            if (og + 1u == (tg + 1u) * nx) xb_add(&bar[XB_TOPGEN], 1u);
            else XB_SPIN(xb_ld(&bar[XB_TOPGEN]) == tg, bar);
            __builtin_amdgcn_fence(__ATOMIC_ACQUIRE, "agent");
            xb_add(&bar[XB_XGEN(b.x)], 1u);
            asm volatile("s_waitcnt vmcnt(0)" ::: "memory");
        } else {
            XB_SPIN(xb_ld(&bar[XB_XGEN(b.x)]) == gen, bar);
            __builtin_amdgcn_fence(__ATOMIC_ACQUIRE, "agent");
            asm volatile("s_waitcnt vmcnt(0)" ::: "memory");
        }
    }
    __syncthreads();
}

struct Args { const float* in[20]; float* out; unsigned char* ws; };
__global__ void __launch_bounds__(512, 2) mk_fwd(Args args) {
    extern __shared__ __attribute__((aligned(16))) unsigned char lds_raw[];
    cg::grid_group grid = cg::this_grid();
    LAS unsigned char* lds = (LAS unsigned char*)lds_raw;
    const int tid = threadIdx.x, lane = tid & 63, wave = __builtin_amdgcn_readfirstlane(tid >> 6);
    const int G = gridDim.x, bid = blockIdx.x, gw = bid * 8 + wave, NGW = G * 8;
    unsigned char* ws = args.ws; float* out = args.out;
    const float* x_prompt = args.in[0]; const float* x_sample = args.in[1];
    bf16* Wgu1 = (bf16*)(ws + WS_WGU1); bf16* Wdn1 = (bf16*)(ws + WS_WDN1); bf16* Win = (bf16*)(ws + WS_WIN); bf16* Wout = (bf16*)(ws + WS_WOUT);
    bf16* Wgu2 = (bf16*)(ws + WS_WGU2); bf16* Wdn2 = (bf16*)(ws + WS_WDN2);
    float* LBV = (float*)(ws + WS_LB); bf16* XN = (bf16*)(ws + WS_XN); bf16* ACT = (bf16*)(ws + WS_ACT); float* Y = (float*)(ws + WS_Y);
    bf16* QE = (bf16*)(ws + WS_QE); bf16* KE = (bf16*)(ws + WS_KE); bf16* VTg = (bf16*)(ws + WS_VT); bf16* UT = (bf16*)(ws + WS_UT); float* Dws = (float*)(ws + WS_D);
    if (tid < 4) ((volatile LAS unsigned*)(lds + LDS_BARW))[tid] = 0u;
    __syncthreads();
    const XcdBarrier xbar = xcd_barrier_post((unsigned*)ws, (volatile LAS unsigned*)(lds + LDS_BARW));
    if (ws == nullptr) grid.sync();
    for (int rep = 0; rep < REP_P0; ++rep) {
        LAS float* scr = (LAS float*)(lds + wave * 16384);
        constexpr int I_GU = 16 * 176, I_DN = 44 * 32, I_IN = 16 * 88, I_OUT = 16 * 32, NITEMS = 2 * I_GU + 2 * I_DN + I_IN + I_OUT;
        for (int it = gw; it < NITEMS; it += NGW) {
            int r = it;
            if (r < I_GU) { tr_item<1>(args.in[7], DM, NGU, args.in[5], Wgu1, scr, r, lane); continue; } r -= I_GU;
            if (r < I_GU) { tr_item<1>(args.in[18], DM, NGU, args.in[16], Wgu2, scr, r, lane); continue; } r -= I_GU;
            if (r < I_DN) { tr_item<0>(args.in[8], DFF, DM, nullptr, Wdn1, scr, r, lane); continue; } r -= I_DN;
            if (r < I_DN) { tr_item<0>(args.in[19], DFF, DM, nullptr, Wdn2, scr, r, lane); continue; } r -= I_DN;
            if (r < I_IN) { tr_item<0>(args.in[11], DM, NIN, args.in[9], Win, scr, r, lane); continue; } r -= I_IN;
            tr_item<0>(args.in[15], DM, DM, nullptr, Wout, scr, r, lane);
        }
        for (int m = gw; m < MPAD; m += NGW) {
            if (m < MTOK) norm_row_to_bf16(m < MPROMPT ? x_prompt + (size_t)m * DM : x_sample + (size_t)(m - MPROMPT) * DM, XN + (size_t)m * DM, lane);
            else { unsigned long long* o8 = (unsigned long long*)(XN + (size_t)m * DM) + lane;
#pragma unroll
                for (int j = 0; j < 4; ++j) o8[64 * j] = 0ull; }
        }
        if (bid == 0) { const float* l = args.in[13]; LBV[tid] = 1.0f / (1.0f + __expf(l[512 + tid] - l[tid])); }
        for (int e = bid * 512 + tid; e < MSAMP * DM / 4; e += G * 512) ((f32x4*)(Y + (size_t)MPROMPT * DM))[e] = (f32x4){0.f, 0.f, 0.f, 0.f};
    }
    xcd_barrier(xbar);
    { pg8::Gemm g{XN, Wgu1, MPAD, NGU, DM, DM}; pg8::StaticOrder S; S.init(MPAD, NGU, G, bid); pg8::EpiSwiGLU E{ACT, DFF};
      pg8::gemm_phase<pg8::EpiSwiGLU, pg8::StaticOrder, true, true>(lds, g, S, E); }
    xcd_barrier(xbar);
    { pg8::Gemm g{ACT, Wdn1, MPROMPT, DM, DFF, DFF}; pg8::StaticOrder S; S.init(MPROMPT, DM, G, bid); pg8::EpiF32 E{Y, DM};
      pg8::gemm_phase<pg8::EpiF32, pg8::StaticOrder, true, true>(lds, g, S, E);
      pg8::Gemm gt{ACT, Wdn1, MPAD, DM, 256, DFF}; pg8::TailOrder T{MPROMPT / 256, 4, 44, 256, (G - 1) - bid}; pg8::EpiAtomicF32 Et{Y, DM};
      pg8::gemm_phase<pg8::EpiAtomicF32, pg8::TailOrder, false, true>(lds, gt, T, Et); }
    xcd_barrier(xbar);
    for (int rep = 0; rep < REP_P3; ++rep)
    for (int m = gw; m < MTOK; m += NGW)
        resid_row(m < MPROMPT ? x_prompt + (size_t)m * DM : x_sample + (size_t)(m - MPROMPT) * DM, Y + (size_t)m * DM, args.in[6], 0.5f, out + (size_t)m * DM, XN + (size_t)m * DM, lane, m >= MPROMPT);
    xcd_barrier(xbar);
    { pg8::Gemm g{XN, Win, MPAD, NIN, DM, DM}; pg8::StaticOrder S; S.init(MPAD, NIN, G, bid); pg8::EpiBf16 E{ACT, NIN};
      pg8::gemm_phase<pg8::EpiBf16, pg8::StaticOrder, true, true>(lds, g, S, E); }
    xcd_barrier(xbar);
    for (int rep = 0; rep < REP_MIX; ++rep) {
    {
        const bf16* P = ACT; bf16* CAT = XN;
        for (int u = bid; u < 256; u += G) attn_prompt_unit(lds, P, CAT, args.in[12], u >> 6, (u >> 1) & 31, u & 1, tid, lane, wave);
        for (int u = gw; u < 2048; u += NGW) hgrn_gate_unit(lds + wave * HG_WAVE_LDS, P, LBV, QE, KE, VTg, UT, Dws, u >> 9, (u >> 6) & 7, u & 63, lane);
        __syncthreads();
        for (int u = bid; u < 256; u += G) attn_sample_unit(lds, P, args.in[2], args.in[3], args.in[12], out, CAT, u >> 1, u & 1, tid, lane, wave);
        for (int u = gw; u < 1024; u += NGW) hgrn_sample_unit(P, LBV, args.in[4], args.in[14], out, CAT, u >> 3, u & 7, lane);
        for (int e = bid * 512 + tid; e < 131072; e += G * 512) {
            const int which = e >> 16, r = e & 65535, b = r >> 14, j = (r >> 7) & 127, kvh = (r >> 6) & 1, d = r & 63;
            const bf16* prow = P + (size_t)(b * SEQ + SEQ - 128 + j) * NIN;
            float v;
            if (which == 0) { const bf16* hp = prow + C_K + 64 * kvh; v = d < 16 ? rope_elem(hp, d, (float)(SEQ - 128 + j)) : bf2f(hp[d]); }
            else v = bf2f(prow[C_V + 64 * kvh + d]);
            out[O_WKP + e] = v;
        }
    }
    xcd_barrier(xbar);
    for (int e = bid * 512 + tid; e < 65536; e += G * 512) {
        const int bh = e >> 11, pr = e & 2047, k0 = (2 * pr) & 63, dv = (2 * pr) >> 6; float S0 = 0.f, S1 = 0.f;
        unsigned* up = (unsigned*)(UT + (size_t)bh * 64 * 4096) + pr; const float* dp = Dws + (size_t)bh * 64 * 64 + k0;
#pragma unroll 1
        for (int c0 = 0; c0 < 64; c0 += 32) { unsigned raw[32]; float2 dd[32];
#pragma unroll
            for (int c = 0; c < 32; ++c) { raw[c] = up[(size_t)(c0 + c) * 2048]; dd[c] = *(const float2*)(dp + (c0 + c) * 64); }
#pragma unroll
            for (int c = 0; c < 32; ++c) { up[(size_t)(c0 + c) * 2048] = pk2(S0, S1); S0 = dd[c].x * S0 + __uint_as_float(raw[c] << 16); S1 = dd[c].y * S1 + __uint_as_float(raw[c] & 0xffff0000u); } }
        out[O_SP + (size_t)bh * 4096 + k0 * 64 + dv] = S0; out[O_SP + (size_t)bh * 4096 + (k0 + 1) * 64 + dv] = S1;
    }
    xcd_barrier(xbar);
    {
        const bf16* P = ACT; bf16* CAT = XN;
        for (int u = gw; u < 2048; u += NGW) hgrn_out_unit(P, QE, KE, VTg, UT, args.in[14], CAT, u >> 9, (u >> 6) & 7, u & 63, lane);
    }
    xcd_barrier(xbar);
    }
    { pg8::Gemm g{XN, Wout, MPROMPT, DM, DM, DM}; pg8::StaticOrder S; S.init(MPROMPT, DM, G, bid); pg8::EpiF32 E{Y, DM};
      pg8::gemm_phase<pg8::EpiF32, pg8::StaticOrder, true, true>(lds, g, S, E);
      pg8::Gemm gt{XN, Wout, MPAD, DM, 128, DM}; pg8::TailOrder T{MPROMPT / 256, 4, 32, 128, (G - 1) - bid}; pg8::EpiAtomicF32 Et{Y, DM};
      pg8::gemm_phase<pg8::EpiAtomicF32, pg8::TailOrder, false, true>(lds, gt, T, Et); }
    xcd_barrier(xbar);
    for (int m = gw; m < MTOK; m += NGW) resid_row(out + (size_t)m * DM, Y + (size_t)m * DM, args.in[10], 1.0f, out + (size_t)m * DM, XN + (size_t)m * DM, lane, m >= MPROMPT);
    xcd_barrier(xbar);
    { pg8::Gemm g{XN, Wgu2, MPAD, NGU, DM, DM}; pg8::StaticOrder S; S.init(MPAD, NGU, G, bid); pg8::EpiSwiGLU E{ACT, DFF};
      pg8::gemm_phase<pg8::EpiSwiGLU, pg8::StaticOrder, true, true>(lds, g, S, E); }
    xcd_barrier(xbar);
    { pg8::Gemm g{ACT, Wdn2, MPROMPT, DM, DFF, DFF}; pg8::StaticOrder S; S.init(MPROMPT, DM, G, bid); pg8::EpiF32 E{Y, DM};
      pg8::gemm_phase<pg8::EpiF32, pg8::StaticOrder, true, true>(lds, g, S, E);
      pg8::Gemm gt{ACT, Wdn2, MPAD, DM, 256, DFF}; pg8::TailOrder T{MPROMPT / 256, 4, 44, 256, (G - 1) - bid}; pg8::EpiAtomicF32 Et{Y, DM};
      pg8::gemm_phase<pg8::EpiAtomicF32, pg8::TailOrder, false, true>(lds, gt, T, Et); }
    xcd_barrier(xbar);
    for (int m = gw; m < MTOK; m += NGW) resid_row(out + (size_t)m * DM, Y + (size_t)m * DM, args.in[17], 0.5f, out + (size_t)m * DM, nullptr, lane, false);
}

extern "C" void kernel_launch(void* const* d_in, const int* in_sizes, int n_in, void* d_out, int out_size, void* d_ws, size_t ws_size, hipStream_t stream) {
    static int grid = 0;
    if (grid == 0) {
        int dev = 0, cus = 0, per_cu = 0;
        (void)hipGetDevice(&dev);
        (void)hipDeviceGetAttribute(&cus, hipDeviceAttributeMultiprocessorCount, dev);
        (void)hipFuncSetAttribute((const void*)mk_fwd, hipFuncAttributeMaxDynamicSharedMemorySize, LDS_BYTES);
        if (hipOccupancyMaxActiveBlocksPerMultiprocessor(&per_cu, (const void*)mk_fwd, 512, LDS_BYTES) != hipSuccess || per_cu < 1) { fprintf(stderr, "occupancy query: %d blocks per CU\n", per_cu); per_cu = 1; }
        (void)hipGetLastError();
        grid = cus * (per_cu > 1 ? 1 : per_cu);
        if (n_in != 20 || ws_size < WS_END) { fprintf(stderr, "kernel_launch: unexpected inputs (n_in %d, ws %zu)\n", n_in, ws_size); grid = -1; }
    }
    if (grid < 0) return;
    if (hipMemsetAsync(d_ws, 0, XCD_BAR_WORDS * 4, stream) != hipSuccess) { fprintf(stderr, "kernel_launch: memset of the barrier words failed\n"); return; }
    Args a{};
    for (int i = 0; i < 20; ++i) a.in[i] = (const float*)d_in[i];
    a.out = (float*)d_out; a.ws = (unsigned char*)d_ws;
    void* kargs[] = {&a};
    hipError_t e = hipLaunchCooperativeKernel((const void*)mk_fwd, dim3(grid), dim3(512), kargs, LDS_BYTES, stream);
    if (e != hipSuccess) fprintf(stderr, "cooperative launch failed: %s (grid %d)\n", hipGetErrorString(e), grid);
}
```

```cpp
#include <hip/hip_runtime.h>
#include <hip/hip_cooperative_groups.h>
#include <cstdio>
#include <cstdint>
namespace cg = cooperative_groups;
#ifndef REP_P0
#define REP_P0 1
#endif
#ifndef REP_MIX
#define REP_MIX 1
#endif
#ifndef REP_P3
#define REP_P3 1
#endif
namespace pg8 {
#define PG8_LAS __attribute__((address_space(3)))
typedef unsigned short bf16_t;
typedef short bf16x8 __attribute__((ext_vector_type(8)));
typedef float f32x4 __attribute__((ext_vector_type(4)));
typedef unsigned u32x4 __attribute__((ext_vector_type(4)));
constexpr int BM = 256, BK = 64, HALF = 128, HTB = HALF * BK * 2  , STAGE_BYTES = 8 * HTB, NXCD = 8, WGM = 8;

__host__ __device__ __forceinline__ int lds_byte(int r, int c) { const int st = (r >> 4) * 2 + (c >> 5), rr = r & 15, cc = c & 31, ob = rr * 64 + cc * 2; return st * 1024 + (ob ^ (((ob >> 9) & 1) << 5)); }
__host__ __device__ __forceinline__ void stage_rc(int b, int& R, int& C) { const int st = b / 1024, sb = b % 1024, swz = sb ^ (((sb >> 9) & 1) << 5); R = (st >> 1) * 16 + swz / 64; C = (st & 1) * 32 + (swz % 64) / 2; }
__host__ __device__ __forceinline__ int perm32(int rho) { const int n = rho >> 4, i = rho & 15; return 8 * (i >> 2) + 4 * n + (i & 3); }

struct Unit { int pm, pn, k0; };
struct Gemm { const bf16_t* A; const bf16_t* Bt; int M, N, K, ld; };

struct StaticOrder {
    int nM, nN, nwg, G, c;
    __host__ __device__ void init(int M, int N, int G_, int c_) { nM = M / BM; nN = N / BM; nwg = nM * nN; G = G_; c = c_; }
    __host__ __device__ bool next(int i, Unit& u) const {
        const long L = (long)i * G + c; if (L >= nwg) return false;
        int wgid = (int)L; { const int q = nwg / NXCD, r = nwg % NXCD, xcd = wgid % NXCD, off = wgid / NXCD; wgid = (xcd < r ? xcd * (q + 1) : r * (q + 1) + (xcd - r) * q) + off; }
        const int nig = WGM * nN, gid = wgid / nig, fm = gid * WGM, gsz = (nM - fm) < WGM ? (nM - fm) : WGM;
        u.pm = fm + ((wgid % nig) % gsz); u.pn = (wgid % nig) / gsz; u.k0 = 0; return true;
    }
    __device__ __forceinline__ void a_ready(const Unit&) const {}
    __device__ __forceinline__ void done(const Unit&) const {}
};

__device__ __forceinline__ unsigned cvt_pk_bf16(float lo, float hi) { unsigned r; asm volatile("v_cvt_pk_bf16_f32 %0, %1, %2" : "=v"(r) : "v"(lo), "v"(hi)); return r; }
typedef float f32x2 __attribute__((ext_vector_type(2)));
struct EpiBf16 {
    static constexpr bool PERM = true, AFTER_DRAIN = false;
    bf16_t* O; int ldc; const float* rs;
    __device__ __forceinline__ void operator()(const f32x4 (&acc)[2][2][4][2], const Unit& u, int wr, int wc, int fr, int fq) const {
        const int row0 = u.pm * BM + wr * 64 + fr; const int col0 = u.pn * BM + wc * 32 + 8 * fq;
#pragma unroll
        for (int ai = 0; ai < 2; ++ai)
#pragma unroll
            for (int m = 0; m < 4; ++m) { const int row = row0 + ai * HALF + m * 16; bf16_t* rowp = O + (size_t)row * ldc + col0; const float r = rs ? rs[row] : 1.0f;
#pragma unroll
                for (int bj = 0; bj < 2; ++bj) { const f32x4 v0 = acc[ai][bj][m][0] * r, v1 = acc[ai][bj][m][1] * r;
                    u32x4 w; w.x = cvt_pk_bf16(v0[0], v0[1]); w.y = cvt_pk_bf16(v0[2], v0[3]); w.z = cvt_pk_bf16(v1[0], v1[1]); w.w = cvt_pk_bf16(v1[2], v1[3]);
                    *(u32x4*)(rowp + bj * HALF) = w; } }
    }
};
__device__ __forceinline__ float silu_f(float g) { return g * __builtin_amdgcn_rcpf(1.0f + __expf(-g)); }
struct EpiSwiGLU {
    static constexpr bool PERM = true, AFTER_DRAIN = false;
    bf16_t* O; int ldc; const float* rs;
    __device__ __forceinline__ void operator()(const f32x4 (&acc)[2][2][4][2], const Unit& u, int wr, int wc, int fr, int fq) const {
        const int row0 = u.pm * BM + wr * 64 + fr; const int col0 = u.pn * HALF + wc * 32 + 8 * fq;
#pragma unroll
        for (int ai = 0; ai < 2; ++ai)
#pragma unroll
            for (int m = 0; m < 4; ++m) { const int row = row0 + ai * HALF + m * 16; bf16_t* rowp = O + (size_t)row * ldc + col0; const float r = rs[row];
                const f32x4 g0 = acc[ai][0][m][0] * r, g1 = acc[ai][0][m][1] * r, u0 = acc[ai][1][m][0] * r, u1 = acc[ai][1][m][1] * r;
                u32x4 w;
                w.x = cvt_pk_bf16(silu_f(g0[0]) * u0[0], silu_f(g0[1]) * u0[1]); w.y = cvt_pk_bf16(silu_f(g0[2]) * u0[2], silu_f(g0[3]) * u0[3]);
                w.z = cvt_pk_bf16(silu_f(g1[0]) * u1[0], silu_f(g1[1]) * u1[1]); w.w = cvt_pk_bf16(silu_f(g1[2]) * u1[2], silu_f(g1[3]) * u1[3]);
                *(u32x4*)rowp = w; }
    }
};
struct EpiF32 {
    static constexpr bool PERM = false, AFTER_DRAIN = false;
    float* O; int ldc;
    __device__ __forceinline__ void operator()(const f32x4 (&acc)[2][2][4][2], const Unit& u, int wr, int wc, int fr, int fq) const {
        const int row0 = u.pm * BM + wr * 64 + fr; const int col0 = u.pn * BM + wc * 32 + 4 * fq;
#pragma unroll
        for (int ai = 0; ai < 2; ++ai)
#pragma unroll
            for (int m = 0; m < 4; ++m) { float* rowp = O + (size_t)(row0 + ai * HALF + m * 16) * ldc + col0;
#pragma unroll
                for (int bj = 0; bj < 2; ++bj)
#pragma unroll
                    for (int n = 0; n < 2; ++n) *(f32x4*)(rowp + bj * HALF + n * 16) = acc[ai][bj][m][n]; }
    }
};
struct TailOrder {
    int pm, nN, nunits, kc, c;
    __device__ bool next(int i, Unit& u) const { if (i != 0 || c >= nunits) return false; u.pm = pm; u.pn = c % nN; u.k0 = (c / nN) * kc; return true; }
    __device__ __forceinline__ void a_ready(const Unit&) const {}
    __device__ __forceinline__ void done(const Unit&) const {}
};
struct EpiAtomicF32 {
    static constexpr bool PERM = false, AFTER_DRAIN = false;
    float* O; int ldc;
    __device__ __forceinline__ void operator()(const f32x4 (&acc)[2][2][4][2], const Unit& u, int wr, int wc, int fr, int fq) const {
        int t_ = threadIdx.x; asm volatile("" : "+v"(t_));
        const int fr_ = t_ & 15, fq_ = (t_ >> 4) & 3;
        const int row0 = u.pm * BM + wr * 64 + fr_; const int col0 = u.pn * BM + wc * 32 + 4 * fq_;
#pragma unroll
        for (int m = 0; m < 4; ++m) { float* rowp = O + (size_t)(row0 + m * 16) * ldc + col0;
#pragma unroll
            for (int bj = 0; bj < 2; ++bj)
#pragma unroll
                for (int n = 0; n < 2; ++n)
#pragma unroll
                    for (int e = 0; e < 4; ++e) __hip_atomic_fetch_add(rowp + bj * HALF + n * 16 + e, acc[0][bj][m][n][e], __ATOMIC_RELAXED, __HIP_MEMORY_SCOPE_AGENT); }
    }
};
template <class Epi, class Sched, bool ALIGN_EPI = false, bool SP2 = false>
__device__ __forceinline__ void gemm_phase(PG8_LAS unsigned char* lds, const Gemm g, const Sched& S, const Epi& E) {
    int tid = threadIdx.x; asm volatile("" : "+v"(tid));
    const int wid = __builtin_amdgcn_readfirstlane(tid >> 6), lane = tid & 63, wr = wid >> 2, wc = wid & 3, fr = lane & 15, fq = lane >> 4;
    const int K = g.ld, nt = g.K / BK;
    unsigned voffA[2], voffB[2];
#pragma unroll
    for (int i = 0; i < 2; ++i) { int R, C; stage_rc(tid * 16 + i * 8192, R, C); const int Rb = Epi::PERM ? ((R & ~31) + perm32(R & 31)) : R;
        voffA[i] = (unsigned)(R * K + C) * 2u; voffB[i] = (unsigned)(Rb * K + C) * 2u; }
    const size_t kstep = (size_t)(BK * 2);
    const size_t hstep = (size_t)HALF * K * 2;
    const size_t tstep = 2 * hstep;
    const unsigned ldsw = (unsigned)wid * 1024u;
    const int aoff = lds_byte(wr * 64 + fr, fq * 8), boff = lds_byte(wc * 32 + fr, fq * 8);
#define PG8_SA(b, h) (((b) * 2 + (h)) * HTB)
#define PG8_SB(b, h) ((4 + (b) * 2 + (h)) * HTB)
#define PG8_STAGE(bufoff, gbase, voff) do { _Pragma("unroll") for (int _i = 0; _i < 2; ++_i) \
        __builtin_amdgcn_global_load_lds((const unsigned*)((const char*)(gbase) + (voff)[_i]), (PG8_LAS unsigned*)(lds + (bufoff) + ldsw + _i * 8192), 16, 0, 0); } while (0)
#define PG8_LDA(dst, b, h) do { _Pragma("unroll") for (int m = 0; m < 4; ++m) _Pragma("unroll") for (int k = 0; k < 2; ++k) dst[m][k] = *(const PG8_LAS bf16x8*)(lds + PG8_SA(b, h) + aoff + m * 2048 + k * 1024); } while (0)
#define PG8_LDB(dst, b, h) do { _Pragma("unroll") for (int n = 0; n < 2; ++n) _Pragma("unroll") for (int k = 0; k < 2; ++k) dst[n][k] = *(const PG8_LAS bf16x8*)(lds + PG8_SB(b, h) + boff + n * 2048 + k * 1024); } while (0)
#define PG8_MMA(ai, bj, At, Bt) do { __builtin_amdgcn_s_setprio(1); _Pragma("unroll") for (int m = 0; m < 4; ++m) _Pragma("unroll") for (int n = 0; n < 2; ++n) _Pragma("unroll") for (int k = 0; k < 2; ++k) \
        acc[ai][bj][m][n] = __builtin_amdgcn_mfma_f32_16x16x32_bf16(Bt[n][k], At[m][k], acc[ai][bj][m][n], 0, 0, 0); __builtin_amdgcn_s_setprio(0); } while (0)
#define PG8_WAIT_V(n) asm volatile("s_waitcnt vmcnt(" #n ")" ::: "memory")
#define PG8_WAIT_L(n) asm volatile("s_waitcnt lgkmcnt(" #n ")" ::: "memory")
#define PG8_BAR __builtin_amdgcn_s_barrier()
#define PG8_SCHED __builtin_amdgcn_sched_barrier(0)
    Unit cur, nxt; int ui = 0;
    if (!S.next(0, cur)) return;
    f32x4 acc[2][2][4][2];
#pragma unroll
    for (int a = 0; a < 2; ++a)
#pragma unroll
        for (int b = 0; b < 2; ++b)
#pragma unroll
            for (int m = 0; m < 4; ++m)
#pragma unroll
                for (int n = 0; n < 2; ++n) acc[a][b][m][n] = (f32x4){0.f, 0.f, 0.f, 0.f};
    bf16x8 At[4][2], B0[2][2], B1[2][2];
    const char* cA = (const char*)g.A + (size_t)cur.pm * tstep + (size_t)cur.k0 * 2; const char* cB = (const char*)g.Bt + (size_t)cur.pn * tstep + (size_t)cur.k0 * 2;
    S.a_ready(cur);
    if constexpr (SP2) {
        PG8_STAGE(PG8_SB(0, 0), cB, voffB); PG8_STAGE(PG8_SB(0, 1), cB + hstep, voffB); PG8_STAGE(PG8_SA(0, 0), cA, voffA); PG8_STAGE(PG8_SA(0, 1), cA + hstep, voffA);
        if (wr == 1) PG8_BAR;
        PG8_WAIT_V(2); PG8_BAR;
        PG8_STAGE(PG8_SB(1, 0), cB + kstep, voffB); PG8_STAGE(PG8_SA(1, 0), cA + kstep, voffA); PG8_STAGE(PG8_SB(1, 1), cB + hstep + kstep, voffB);
        PG8_WAIT_V(6); PG8_BAR;
    } else {
        PG8_STAGE(PG8_SB(0, 0), cB, voffB); PG8_STAGE(PG8_SA(0, 0), cA, voffA); PG8_STAGE(PG8_SB(0, 1), cB + hstep, voffB); PG8_STAGE(PG8_SA(0, 1), cA + hstep, voffA);
        if (wr == 1) PG8_BAR;
        PG8_WAIT_V(4); PG8_BAR;
        PG8_STAGE(PG8_SB(1, 0), cB + kstep, voffB); PG8_STAGE(PG8_SA(1, 0), cA + kstep, voffA); PG8_STAGE(PG8_SB(1, 1), cB + hstep + kstep, voffB);
        PG8_WAIT_V(6); PG8_BAR;
    }
    for (;;) {
        const bool has_next = S.next(ui + 1, nxt);
        const char* nA = has_next ? (const char*)g.A + (size_t)nxt.pm * tstep + (size_t)nxt.k0 * 2 : cA; const char* nB = has_next ? (const char*)g.Bt + (size_t)nxt.pn * tstep + (size_t)nxt.k0 * 2 : cB;
        for (int t = 0; t < nt; t += 2) {
            const bool last = (t == nt - 2);
            const char* a1 = cA + (size_t)(t + 1) * kstep;
            const char* a2 = last ? nA : cA + (size_t)(t + 2) * kstep; const char* b2 = last ? nB : cB + (size_t)(t + 2) * kstep;
            const char* a3 = a2 + kstep; const char* b3 = b2 + kstep;
            if (last && has_next) S.a_ready(nxt);
            if constexpr (SP2) {
            PG8_LDB(B0, 0, 0); PG8_LDB(B1, 0, 1); PG8_SCHED; PG8_LDA(At, 0, 0); PG8_STAGE(PG8_SA(1, 1), a1 + hstep, voffA);
            PG8_WAIT_V(8); PG8_WAIT_L(0); PG8_BAR; PG8_MMA(0, 0, At, B0); PG8_MMA(0, 1, At, B1); PG8_BAR; PG8_SCHED;
            PG8_LDA(At, 0, 1); PG8_STAGE(PG8_SB(0, 0), b2, voffB); PG8_STAGE(PG8_SB(0, 1), b2 + hstep, voffB); PG8_STAGE(PG8_SA(0, 0), a2, voffA);
            PG8_WAIT_V(8); PG8_WAIT_L(0); PG8_BAR; PG8_MMA(1, 0, At, B0); PG8_MMA(1, 1, At, B1); PG8_BAR; PG8_SCHED;
            PG8_LDB(B0, 1, 0); PG8_LDB(B1, 1, 1); PG8_SCHED; PG8_LDA(At, 1, 0); PG8_STAGE(PG8_SA(0, 1), a2 + hstep, voffA);
            PG8_WAIT_V(8); PG8_WAIT_L(0); PG8_BAR; PG8_MMA(0, 0, At, B0); PG8_MMA(0, 1, At, B1); PG8_BAR; PG8_SCHED;
            PG8_LDA(At, 1, 1); PG8_STAGE(PG8_SB(1, 0), b3, voffB); PG8_STAGE(PG8_SB(1, 1), b3 + hstep, voffB); PG8_STAGE(PG8_SA(1, 0), a3, voffA);
            PG8_WAIT_V(8); PG8_WAIT_L(0); PG8_BAR; PG8_MMA(1, 0, At, B0); PG8_MMA(1, 1, At, B1); PG8_BAR; PG8_SCHED;
            } else {
            PG8_LDB(B0, 0, 0); PG8_SCHED; PG8_LDA(At, 0, 0); PG8_STAGE(PG8_SA(1, 1), a1 + hstep, voffA);
            PG8_WAIT_L(8); PG8_BAR; PG8_WAIT_L(0); PG8_MMA(0, 0, At, B0); PG8_BAR; PG8_SCHED;
            PG8_LDB(B1, 0, 1); PG8_STAGE(PG8_SB(0, 0), b2, voffB);
            PG8_BAR; PG8_WAIT_L(0); PG8_MMA(0, 1, At, B1); PG8_BAR;
            PG8_LDA(At, 0, 1); PG8_STAGE(PG8_SA(0, 0), a2, voffA);
            PG8_BAR; PG8_WAIT_L(0); PG8_MMA(1, 0, At, B0); PG8_BAR; PG8_SCHED;
            PG8_STAGE(PG8_SB(0, 1), b2 + hstep, voffB);
            PG8_WAIT_V(6); PG8_BAR; PG8_MMA(1, 1, At, B1); PG8_BAR;
            PG8_LDB(B0, 1, 0); PG8_SCHED; PG8_LDA(At, 1, 0); PG8_STAGE(PG8_SA(0, 1), a2 + hstep, voffA);
            PG8_WAIT_L(8); PG8_BAR; PG8_WAIT_L(0); PG8_MMA(0, 0, At, B0); PG8_BAR; PG8_SCHED;
            PG8_LDB(B1, 1, 1); PG8_STAGE(PG8_SB(1, 0), b3, voffB);
            PG8_BAR; PG8_WAIT_L(0); PG8_MMA(0, 1, At, B1); PG8_BAR;
            PG8_LDA(At, 1, 1); PG8_STAGE(PG8_SA(1, 0), a3, voffA);
            PG8_BAR; PG8_WAIT_L(0); PG8_MMA(1, 0, At, B0); PG8_BAR; PG8_SCHED;
            PG8_STAGE(PG8_SB(1, 1), b3 + hstep, voffB);
            PG8_WAIT_V(6); PG8_BAR; PG8_MMA(1, 1, At, B1); PG8_BAR;
            }
        }
        if constexpr (ALIGN_EPI) { if (wr == 0) PG8_BAR; }
        if constexpr (!Epi::AFTER_DRAIN) { E(acc, cur, wr, wc, fr, fq); S.done(cur); }
        if (!has_next) break;
#pragma unroll
        for (int a = 0; a < 2; ++a)
#pragma unroll
            for (int b = 0; b < 2; ++b)
#pragma unroll
                for (int m = 0; m < 4; ++m)
#pragma unroll
                    for (int n = 0; n < 2; ++n) acc[a][b][m][n] = (f32x4){0.f, 0.f, 0.f, 0.f};
        cur = nxt; cA = nA; cB = nB; ++ui;
        if constexpr (ALIGN_EPI) { if (wr == 1) PG8_BAR; }
    }
    PG8_WAIT_V(0);
    if constexpr (!ALIGN_EPI) { if (wr == 0) PG8_BAR; }
    PG8_BAR;
    if constexpr (Epi::AFTER_DRAIN) { E.fused(acc, cur, wr, wc, fr, fq, lds, wid, lane); S.done(cur); }
#undef PG8_SA
#undef PG8_SB
#undef PG8_STAGE
#undef PG8_LDA
#undef PG8_LDB
#undef PG8_MMA
#undef PG8_WAIT_V
#undef PG8_WAIT_L
#undef PG8_BAR
#undef PG8_SCHED
}
}

constexpr int DM = 1024, SEQ = 4096, NBATCH = 4, MPROMPT = 16384, MSAMP = 128, MTOK = 16512, MPAD = 16640, DFF = 2816, NGU = 5632, NIN = 2816;
constexpr int C_Q = 0, C_K = 512, C_V = 640, C_HQ = 768, C_HF = 1280, C_HI = 1792, C_HG = 2304;
constexpr float EPS = 1e-6f;
constexpr float LOG2E = 1.4426950408889634f;
constexpr float PAST_POS = 8192.0f;
constexpr size_t O_WKP = (size_t)MTOK * DM, O_WVP = O_WKP + 65536, O_SP = O_WVP + 65536, O_WKS = O_SP + 131072, O_WVS = O_WKS + 2097152, O_SS = O_WVS + 2097152;
constexpr size_t MiB = 1u << 20;
constexpr size_t WS_WGU1 = 1 * MiB, WS_WDN1 = 12 * MiB, WS_WIN = 18 * MiB, WS_WOUT = 24 * MiB, WS_WGU2 = 26 * MiB, WS_WDN2 = 37 * MiB;
constexpr size_t WS_YS = MiB / 2;
constexpr size_t WS_LB = 43 * MiB;
constexpr size_t WS_D = WS_LB + 65536;
constexpr size_t WS_RS = WS_LB + 655360;
constexpr size_t WS_XA = 44 * MiB;
constexpr size_t WS_ACT = 77 * MiB;
constexpr size_t WS_CAT = 167 * MiB;
constexpr size_t WS_Y = 200 * MiB;
constexpr size_t WS_QE = 200 * MiB, WS_KE = 216 * MiB, WS_VT = 232 * MiB, WS_UT = 1 * MiB;
constexpr size_t WS_END = 248 * MiB;
static_assert(WS_XA + (size_t)MPAD * DM * 2 <= WS_ACT && WS_ACT + (size_t)MPAD * DFF * 2 <= WS_CAT && WS_CAT + (size_t)MPAD * DM * 2 <= WS_Y && WS_Y + (size_t)MPROMPT * DM * 2 <= WS_VT && WS_RS + MPAD * 4 <= WS_XA, "ws map");

constexpr int LDS_BYTES = 148480;
constexpr int LDS_BARW = 147456;

#define GAS __attribute__((address_space(1)))
#define LAS __attribute__((address_space(3)))
typedef unsigned short bf16;
typedef unsigned v4u __attribute__((ext_vector_type(4)));
typedef float f32x4 __attribute__((ext_vector_type(4)));
typedef short bf16x8 __attribute__((ext_vector_type(8)));
#define LDS_WAIT() asm volatile("s_waitcnt lgkmcnt(0)" ::: "memory")
#define DI __device__ __forceinline__

DI unsigned f2bf(float f) { unsigned u = __builtin_bit_cast(unsigned, f); return (u + 0x7fffu + ((u >> 16) & 1u)) >> 16; }
DI unsigned pk2(float lo, float hi) { return f2bf(lo) | (f2bf(hi) << 16); }
DI float bf2f(unsigned short h) { return __uint_as_float(((unsigned)h) << 16); }
DI float wave_sum(float v) {
#pragma unroll
    for (int o = 1; o < 64; o <<= 1) v += __shfl_xor(v, o);
    return v;
}
DI float wave_max(float v) {
#pragma unroll
    for (int o = 1; o < 64; o <<= 1) v = fmaxf(v, __shfl_xor(v, o));
    return v;
}
DI float sigmoid_f(float x) { return __builtin_amdgcn_rcpf(1.0f + __expf(-x)); }
DI float silu2_f(float x) { return x * sigmoid_f(x); }
DI void rope_cs(float pos, int i, float& c, float& s) {
    const float inv = __builtin_amdgcn_exp2f(-(float)i * 2.3664460711655217f);
    float rev = (pos * inv) * 0.15915494309189535f;
    rev = rev - floorf(rev);
    s = __builtin_amdgcn_sinf(rev); c = __builtin_amdgcn_cosf(rev);
}
DI void unpack8(const v4u raw, float (&f)[8]) {
#pragma unroll
    for (int i = 0; i < 4; ++i) { f[2 * i] = __uint_as_float(raw[i] << 16); f[2 * i + 1] = __uint_as_float(raw[i] & 0xffff0000u); }
}
DI v4u pack8(const float (&f)[8]) { v4u o; o.x = pk2(f[0], f[1]); o.y = pk2(f[2], f[3]); o.z = pk2(f[4], f[5]); o.w = pk2(f[6], f[7]); return o; }
DI float rope_elem(const bf16* hp, int d, float pos) {
    const int i = d & 7; float c, s; rope_cs(pos, i, c, s);
    const float x1 = bf2f(hp[i]), x2 = bf2f(hp[i + 8]);
    return d < 8 ? x1 * c - x2 * s : x2 * c + x1 * s;
}

template <int MODE> DI void tr_item(const float* W, int K, int N, const float* gain, bf16* WT, LAS float* scr, int item, int lane) {
    const int nblk = N / 32, kb = item / nblk, nb = item % nblk, k0 = 64 * kb, n0 = 32 * nb;
#pragma unroll
    for (int i = 0; i < 32; ++i) { const int kk = 2 * i + (lane >> 5); float w = W[(size_t)(k0 + kk) * N + n0 + (lane & 31)]; if (gain) w *= gain[k0 + kk]; scr[kk * 33 + (lane & 31)] = w; }
    LDS_WAIT(); asm volatile("" ::: "memory");
    const int c = lane & 7;
#pragma unroll
    for (int j = 0; j < 4; ++j) { const int n = (lane >> 3) + 8 * j; const LAS float* s = scr + (8 * c) * 33 + n;
        v4u o; o.x = pk2(s[0 * 33], s[1 * 33]); o.y = pk2(s[2 * 33], s[3 * 33]); o.z = pk2(s[4 * 33], s[5 * 33]); o.w = pk2(s[6 * 33], s[7 * 33]);
        const int ns = n0 + n; int drow = ns;
        if (MODE == 1) drow = ns < DFF ? ((ns >> 7) * 256 + (ns & 127)) : (((ns - DFF) >> 7) * 256 + 128 + ((ns - DFF) & 127));
        *(v4u*)(WT + (size_t)drow * K + k0 + 8 * c) = o; }
    LDS_WAIT(); asm volatile("" ::: "memory");
}
template <int MODE> DI void tr_item64(const float* W, int K, int N, const float* gain, bf16* WT, LAS float* scr, int item, int lane) {
    const int nblk = N / 64, kb = item / nblk, nb = item % nblk, k0 = 64 * kb, n0 = 64 * nb;
    const int kr = lane >> 4, nc = lane & 15;
    f32x4 v[16];
#pragma unroll
    for (int it = 0; it < 16; ++it) v[it] = *(const f32x4*)(W + (size_t)(k0 + 4 * it + kr) * N + n0 + 4 * nc);
#pragma unroll
    for (int it = 0; it < 16; ++it) { const int k = 4 * it + kr; const float gk = gain ? gain[k0 + k] : 1.0f;
        scr[(4 * nc + 0) * 65 + k] = v[it].x * gk; scr[(4 * nc + 1) * 65 + k] = v[it].y * gk; scr[(4 * nc + 2) * 65 + k] = v[it].z * gk; scr[(4 * nc + 3) * 65 + k] = v[it].w * gk; }
    LDS_WAIT(); asm volatile("" ::: "memory");
    const int c = lane & 7;
#pragma unroll
    for (int j = 0; j < 8; ++j) { const int n = (lane >> 3) + 8 * j; const LAS float* sp = scr + n * 65 + 8 * c;
        v4u o; o.x = pk2(sp[0], sp[1]); o.y = pk2(sp[2], sp[3]); o.z = pk2(sp[4], sp[5]); o.w = pk2(sp[6], sp[7]);
        const int ns = n0 + n; int drow = ns;
        if (MODE == 1) drow = ns < DFF ? ((ns >> 7) * 256 + (ns & 127)) : (((ns - DFF) >> 7) * 256 + 128 + ((ns - DFF) & 127));
        *(v4u*)(WT + (size_t)drow * K + k0 + 8 * c) = o; }
    LDS_WAIT(); asm volatile("" ::: "memory");
}
DI void norm_row_to_bf16(const float* xrow, bf16* orow, int lane) {
    const f32x4* xr = (const f32x4*)xrow + lane;
    f32x4 v[4]; float s = 0.f;
#pragma unroll
    for (int j = 0; j < 4; ++j) { v[j] = xr[64 * j]; s += (v[j].x * v[j].x + v[j].y * v[j].y) + (v[j].z * v[j].z + v[j].w * v[j].w); }
    const float r = __builtin_amdgcn_rsqf(wave_sum(s) * (1.f / DM) + EPS);
    unsigned long long* o8 = (unsigned long long*)orow + lane;
#pragma unroll
    for (int j = 0; j < 4; ++j) o8[64 * j] = (unsigned long long)pk2(v[j].x * r, v[j].y * r) | ((unsigned long long)pk2(v[j].z * r, v[j].w * r) << 32);
}
DI void resid_row(const float* xrow, const float* yrow, const float* g, float coef, float* orow, bf16* xnrow, int lane, bool zero_y) {
    const f32x4* xr = (const f32x4*)xrow + lane; const f32x4* yr = (const f32x4*)yrow + lane; const f32x4* gr = (const f32x4*)g + lane;
    f32x4 xv[4], yv[4]; float s = 0.f;
#pragma unroll
    for (int j = 0; j < 4; ++j) { xv[j] = xr[64 * j]; yv[j] = yr[64 * j]; s += (yv[j].x * yv[j].x + yv[j].y * yv[j].y) + (yv[j].z * yv[j].z + yv[j].w * yv[j].w); }
    if (zero_y) {
#pragma unroll
        for (int j = 0; j < 4; ++j) ((f32x4*)yrow + lane)[64 * j] = (f32x4){0.f, 0.f, 0.f, 0.f}; }
    const float ry = __builtin_amdgcn_rsqf(wave_sum(s) * (1.f / DM) + EPS) * coef;
    float s2 = 0.f;
#pragma unroll
    for (int j = 0; j < 4; ++j) { const f32x4 gv = gr[64 * j]; xv[j] = xv[j] + (yv[j] * ry) * gv; s2 += (xv[j].x * xv[j].x + xv[j].y * xv[j].y) + (xv[j].z * xv[j].z + xv[j].w * xv[j].w); }
    f32x4* orp = (f32x4*)orow + lane;
#pragma unroll
    for (int j = 0; j < 4; ++j) orp[64 * j] = xv[j];
    if (xnrow) {
        const float r = __builtin_amdgcn_rsqf(wave_sum(s2) * (1.f / DM) + EPS);
        unsigned long long* o8 = (unsigned long long*)xnrow + lane;
#pragma unroll
        for (int j = 0; j < 4; ++j) o8[64 * j] = (unsigned long long)pk2(xv[j].x * r, xv[j].y * r) | ((unsigned long long)pk2(xv[j].z * r, xv[j].w * r) << 32);
    }
}

DI f32x4 ld4_bf16(const bf16* row, int idx) { const uint2 raw = ((const uint2*)row)[idx]; return (f32x4){__uint_as_float(raw.x << 16), __uint_as_float(raw.x & 0xffff0000u), __uint_as_float(raw.y << 16), __uint_as_float(raw.y & 0xffff0000u)}; }
template <bool XBF, bool OUTF32> DI void resid_row2(const void* xrow, const bf16* ybf, float* ysamp, const float* g, float coef, void* orow, float* rs, int lane) {
    f32x4 xv[4], yv[4]; float s = 0.f;
#pragma unroll
    for (int j = 0; j < 4; ++j) {
        xv[j] = XBF ? ld4_bf16((const bf16*)xrow, lane + 64 * j) : ((const f32x4*)xrow)[lane + 64 * j];
        yv[j] = ysamp ? ((const f32x4*)ysamp)[lane + 64 * j] : ld4_bf16(ybf, lane + 64 * j);
        s += (yv[j].x * yv[j].x + yv[j].y * yv[j].y) + (yv[j].z * yv[j].z + yv[j].w * yv[j].w); }
    if (ysamp) {
#pragma unroll
        for (int j = 0; j < 4; ++j) ((f32x4*)ysamp)[lane + 64 * j] = (f32x4){0.f, 0.f, 0.f, 0.f}; }
    const float ry = __builtin_amdgcn_rsqf(wave_sum(s) * (1.f / DM) + EPS) * coef;
    float s2 = 0.f;
#pragma unroll
    for (int j = 0; j < 4; ++j) { const f32x4 gv = ((const f32x4*)g)[lane + 64 * j]; xv[j] = xv[j] + (yv[j] * ry) * gv; s2 += (xv[j].x * xv[j].x + xv[j].y * xv[j].y) + (xv[j].z * xv[j].z + xv[j].w * xv[j].w); }
    if (OUTF32) {
#pragma unroll
        for (int j = 0; j < 4; ++j) ((f32x4*)orow)[lane + 64 * j] = xv[j];
    } else {
        const float r = __builtin_amdgcn_rsqf(wave_sum(s2) * (1.f / DM) + EPS);
#pragma unroll
        for (int j = 0; j < 4; ++j) { uint2 w; w.x = pk2(xv[j].x, xv[j].y); w.y = pk2(xv[j].z, xv[j].w); ((uint2*)orow)[lane + 64 * j] = w; }
        if (lane == 0) *rs = r;
    }
}
DI void cvt_row_to_bf16(const float* xrow, bf16* orow, float* rs, int lane) {
    f32x4 v[4]; float s = 0.f;
#pragma unroll
    for (int j = 0; j < 4; ++j) { v[j] = ((const f32x4*)xrow)[lane + 64 * j]; s += (v[j].x * v[j].x + v[j].y * v[j].y) + (v[j].z * v[j].z + v[j].w * v[j].w); }
    const float r = __builtin_amdgcn_rsqf(wave_sum(s) * (1.f / DM) + EPS);
#pragma unroll
    for (int j = 0; j < 4; ++j) { uint2 w; w.x = pk2(v[j].x, v[j].y); w.y = pk2(v[j].z, v[j].w); ((uint2*)orow)[lane + 64 * j] = w; }
    if (lane == 0) *rs = r;
}

template <bool XBF, bool OUTF32, int R> DI void resid_rows(const float* xp, const float* xs, const bf16* XAin, const bf16* Yb, float* YS, const float* g, float coef, float* outf, bf16* XAout, float* RS, int m0, int mstride, int lane) {
    f32x4 xv[R][4], yv[R][4];
#pragma unroll
    for (int i = 0; i < R; ++i) { const int m = m0 + i * mstride;
        if (m < MTOK) {
            const float* xf = m < MPROMPT ? xp + (size_t)m * DM : xs + (size_t)(m - MPROMPT) * DM;
#pragma unroll
            for (int j = 0; j < 4; ++j) {
                xv[i][j] = XBF ? ld4_bf16(XAin + (size_t)m * DM, lane + 64 * j) : ((const f32x4*)xf)[lane + 64 * j];
                yv[i][j] = m >= MPROMPT ? ((const f32x4*)(YS + (size_t)(m - MPROMPT) * DM))[lane + 64 * j] : ld4_bf16(Yb + (size_t)m * DM, lane + 64 * j); }
        } }
#pragma unroll
    for (int i = 0; i < R; ++i) { const int m = m0 + i * mstride;
        if (m < MTOK) {
            float s = 0.f;
#pragma unroll
            for (int j = 0; j < 4; ++j) s += (yv[i][j].x * yv[i][j].x + yv[i][j].y * yv[i][j].y) + (yv[i][j].z * yv[i][j].z + yv[i][j].w * yv[i][j].w);
            if (m >= MPROMPT) {
#pragma unroll
                for (int j = 0; j < 4; ++j) ((f32x4*)(YS + (size_t)(m - MPROMPT) * DM))[lane + 64 * j] = (f32x4){0.f, 0.f, 0.f, 0.f}; }
            const float ry = __builtin_amdgcn_rsqf(wave_sum(s) * (1.f / DM) + EPS) * coef;
            float s2 = 0.f;
#pragma unroll
            for (int j = 0; j < 4; ++j) { const f32x4 gv = ((const f32x4*)g)[lane + 64 * j]; const f32x4 o = xv[i][j] + (yv[i][j] * ry) * gv; xv[i][j] = o; s2 += (o.x * o.x + o.y * o.y) + (o.z * o.z + o.w * o.w); }
            if (OUTF32) {
#pragma unroll
                for (int j = 0; j < 4; ++j) ((f32x4*)(outf + (size_t)m * DM))[lane + 64 * j] = xv[i][j];
            } else {
                const float r = __builtin_amdgcn_rsqf(wave_sum(s2) * (1.f / DM) + EPS);
#pragma unroll
                for (int j = 0; j < 4; ++j) { uint2 w; w.x = pk2(xv[i][j].x, xv[i][j].y); w.y = pk2(xv[i][j].z, xv[i][j].w); ((uint2*)(XAout + (size_t)m * DM))[lane + 64 * j] = w; }
                if (lane == 0) RS[m] = r;
            }
        } }
}
template <int R> DI void cvt_rows(const float* xp, const float* xs, bf16* XA, float* RS, int m0, int mstride, int lane) {
    f32x4 v[R][4];
#pragma unroll
    for (int i = 0; i < R; ++i) { const int m = m0 + i * mstride;
        if (m < MTOK) { const float* xf = m < MPROMPT ? xp + (size_t)m * DM : xs + (size_t)(m - MPROMPT) * DM;
#pragma unroll
            for (int j = 0; j < 4; ++j) v[i][j] = ((const f32x4*)xf)[lane + 64 * j]; } }
#pragma unroll
    for (int i = 0; i < R; ++i) { const int m = m0 + i * mstride;
        if (m < MTOK) { float s = 0.f;
#pragma unroll
            for (int j = 0; j < 4; ++j) s += (v[i][j].x * v[i][j].x + v[i][j].y * v[i][j].y) + (v[i][j].z * v[i][j].z + v[i][j].w * v[i][j].w);
            const float r = __builtin_amdgcn_rsqf(wave_sum(s) * (1.f / DM) + EPS);
#pragma unroll
            for (int j = 0; j < 4; ++j) { uint2 w; w.x = pk2(v[i][j].x, v[i][j].y); w.y = pk2(v[i][j].z, v[i][j].w); ((uint2*)(XA + (size_t)m * DM))[lane + 64 * j] = w; }
            if (lane == 0) RS[m] = r;
        } else if (m < MPAD) {
#pragma unroll
            for (int j = 0; j < 4; ++j) ((uint2*)(XA + (size_t)m * DM))[lane + 64 * j] = (uint2){0u, 0u};
            if (lane == 0) RS[m] = 0.f; } }
}

#define MFMA16(a, b, c) __builtin_amdgcn_mfma_f32_16x16x32_bf16((a), (b), (c), 0, 0, 0)

constexpr int AT_KS = 0, AT_KS_ROW = 144, AT_VT = 36864, AT_VT_ROW = 528, AT_PS = AT_VT + 64 * 528, AT_PS_WAVE = 16 * 528;
static_assert(AT_PS + 8 * AT_PS_WAVE <= LDS_BYTES, "attention LDS");
DI void attn_prompt_unit(LAS unsigned char* lds, const bf16* P, bf16* CAT, const float* sinks, int b, int nbk, int kvh, int tid, int lane, int wave) {
    {
        const int kj = tid >> 1, half = tid & 1; const int t = 128 * (nbk - 1) + kj;
        LAS unsigned char* krow = lds + AT_KS + kj * AT_KS_ROW + half * 64;
        LAS bf16* vt = (LAS bf16*)(lds + AT_VT);
        if (t < 0) {
            const v4u z = (v4u){0u, 0u, 0u, 0u};
#pragma unroll
            for (int c = 0; c < 4; ++c) *(LAS v4u*)(krow + 16 * c) = z;
#pragma unroll
            for (int i = 0; i < 32; ++i) vt[(32 * half + i) * (AT_VT_ROW / 2) + kj] = 0;
        } else {
            const bf16* prow = P + (size_t)(b * SEQ + t) * NIN;
            const v4u* kp = (const v4u*)(prow + C_K + 64 * kvh + 32 * half);
            v4u c0 = kp[0], c1 = kp[1], c2 = kp[2], c3 = kp[3];
            if (half == 0) {
                float x1[8], x2[8], o1[8], o2[8]; unpack8(c0, x1); unpack8(c1, x2);
#pragma unroll
                for (int i = 0; i < 8; ++i) { float c, s; rope_cs((float)t, i, c, s); o1[i] = x1[i] * c - x2[i] * s; o2[i] = x2[i] * c + x1[i] * s; }
                c0 = pack8(o1); c1 = pack8(o2);
            }
            *(LAS v4u*)(krow) = c0; *(LAS v4u*)(krow + 16) = c1; *(LAS v4u*)(krow + 32) = c2; *(LAS v4u*)(krow + 48) = c3;
            const v4u* vp = (const v4u*)(prow + C_V + 64 * kvh + 32 * half);
#pragma unroll
            for (int c = 0; c < 4; ++c) { const v4u raw = vp[c];
#pragma unroll
                for (int i = 0; i < 4; ++i) { vt[(32 * half + 8 * c + 2 * i) * (AT_VT_ROW / 2) + kj] = (bf16)(raw[i] & 0xffffu); vt[(32 * half + 8 * c + 2 * i + 1) * (AT_VT_ROW / 2) + kj] = (bf16)(raw[i] >> 16); } }
        }
    }
    __syncthreads();
    const int g = wave >> 1, qhalf = wave & 1, h = 4 * kvh + g, fr = lane & 15, fq = lane >> 4;
    const float sink2 = sinks[h] * LOG2E;
    LAS unsigned char* ps = lds + AT_PS + wave * AT_PS_WAVE;
#pragma unroll 1
    for (int sb = 0; sb < 4; ++sb) {
        const int q0 = 64 * qhalf + 16 * sb;
        bf16x8 qa[2];
        {
            const int qi = q0 + fr; const int t = 128 * nbk + qi;
            const bf16* qp = P + (size_t)(b * SEQ + t) * NIN + C_Q + 64 * h;
            v4u r0 = *(const v4u*)(qp + 8 * fq), r1 = *(const v4u*)(qp + 32 + 8 * fq);
            if (fq < 2) {
                const v4u other = *(const v4u*)(qp + 8 * (fq ^ 1));
                float a[8], o[8], x[8]; unpack8(r0, a); unpack8(other, o);
#pragma unroll
                for (int i = 0; i < 8; ++i) { float c, s; rope_cs((float)t, i, c, s); x[i] = fq == 0 ? a[i] * c - o[i] * s : a[i] * c + o[i] * s; }
                r0 = pack8(x);
            }
            qa[0] = __builtin_bit_cast(bf16x8, r0); qa[1] = __builtin_bit_cast(bf16x8, r1);
        }
        f32x4 sc[16];
#pragma unroll
        for (int n = 0; n < 16; ++n) {
            sc[n] = (f32x4){0.f, 0.f, 0.f, 0.f};
#pragma unroll
            for (int ks = 0; ks < 2; ++ks) { const bf16x8 kb = *(const LAS bf16x8*)(lds + AT_KS + (16 * n + fr) * AT_KS_ROW + (32 * ks + 8 * fq) * 2); sc[n] = MFMA16(qa[ks], kb, sc[n]); }
        }
        float mx[4], sm[4];
#pragma unroll
        for (int j = 0; j < 4; ++j) {
            const int qi = q0 + 4 * fq + j; float m = -1e30f;
#pragma unroll
            for (int n = 0; n < 16; ++n) { const int kj = 16 * n + fr; const bool valid = (kj > qi) && (kj <= qi + 128) && (nbk > 0 || kj >= 128);
                const float v = valid ? sc[n][j] * (0.125f * LOG2E) : -1e30f; sc[n][j] = v; m = fmaxf(m, v); }
            m = fmaxf(m, __shfl_xor(m, 1)); m = fmaxf(m, __shfl_xor(m, 2)); m = fmaxf(m, __shfl_xor(m, 4)); m = fmaxf(m, __shfl_xor(m, 8));
            m = fmaxf(m, sink2); mx[j] = m;
            float s = 0.f;
#pragma unroll
            for (int n = 0; n < 16; ++n) { const float p = __builtin_amdgcn_exp2f(sc[n][j] - m); sc[n][j] = p; s += p; }
            s += __shfl_xor(s, 1); s += __shfl_xor(s, 2); s += __shfl_xor(s, 4); s += __shfl_xor(s, 8);
            sm[j] = __builtin_amdgcn_rcpf(s + __builtin_amdgcn_exp2f(sink2 - m));
        }
#pragma unroll
        for (int n = 0; n < 16; ++n)
#pragma unroll
            for (int j = 0; j < 4; ++j) *(LAS bf16*)(ps + (4 * fq + j) * AT_VT_ROW + (16 * n + fr) * 2) = (bf16)f2bf(sc[n][j]);
        LDS_WAIT(); asm volatile("" ::: "memory");
        f32x4 o[4];
#pragma unroll
        for (int n = 0; n < 4; ++n) o[n] = (f32x4){0.f, 0.f, 0.f, 0.f};
#pragma unroll
        for (int ks = 0; ks < 8; ++ks) { const bf16x8 pa = *(const LAS bf16x8*)(ps + fr * AT_VT_ROW + (32 * ks + 8 * fq) * 2);
#pragma unroll
            for (int n = 0; n < 4; ++n) { const bf16x8 vb = *(const LAS bf16x8*)(lds + AT_VT + (16 * n + fr) * AT_VT_ROW + (32 * ks + 8 * fq) * 2); o[n] = MFMA16(pa, vb, o[n]); } }
        LDS_WAIT(); asm volatile("" ::: "memory");
#pragma unroll
        for (int j = 0; j < 4; ++j) { bf16* op = CAT + (size_t)(b * SEQ + 128 * nbk + q0 + 4 * fq + j) * DM + 64 * h + fr;
#pragma unroll
            for (int n = 0; n < 4; ++n) op[16 * n] = (bf16)f2bf(o[n][j] * sm[j]); }
    }
    __syncthreads();
}

constexpr int HG_ROW = 144, HG_WAVE_LDS = 18432;
DI void hgrn_gate_unit(LAS unsigned char* ldsw, const bf16* P, const float* lbv, bf16* QE, bf16* KE, bf16* VTg, bf16* UT, float* Dws, int b, int h, int c, int lane) {
    const int r0 = b * SEQ + 64 * c, unit = (b * 8 + h) * 64 + c, fr = lane & 15, fq = lane >> 4;
    const float lb = lbv[64 * h + lane];
    const bf16* pp = P + (size_t)r0 * NIN + 64 * h + lane;
    bf16* qep = QE + (size_t)r0 * 512 + 64 * h + lane; bf16* kep = KE + (size_t)r0 * 512 + 64 * h + lane;
    {
        unsigned w[64];
#pragma unroll
        for (int t = 0; t < 64; ++t) w[t] = pp[(size_t)t * NIN + C_HI];
#pragma unroll
        for (int s8 = 0; s8 < 8; ++s8) {
            const v4u o = (v4u){w[8 * s8] | (w[8 * s8 + 1] << 16), w[8 * s8 + 2] | (w[8 * s8 + 3] << 16), w[8 * s8 + 4] | (w[8 * s8 + 5] << 16), w[8 * s8 + 6] | (w[8 * s8 + 7] << 16)};
            *(LAS v4u*)(ldsw + 9216 + lane * HG_ROW + 16 * s8) = o;
            *(v4u*)(VTg + (size_t)unit * 4096 + lane * 64 + 8 * s8) = o; }
    }
    float ke[64]; float run = 0.f;
    {
        unsigned short hfr[64], hqr[64];
#pragma unroll
        for (int t = 0; t < 64; ++t) { hfr[t] = pp[(size_t)t * NIN + C_HF]; hqr[t] = pp[(size_t)t * NIN + C_HQ]; }
#pragma unroll
        for (int t = 0; t < 64; ++t) {
            const float hf = bf2f(hfr[t]), hq = bf2f(hqr[t]);
            const float f = lb + (1.0f - lb) * sigmoid_f(hf); run += __logf(f);
            qep[t * 512] = (bf16)f2bf(hq * 0.125f * __expf(run));
            const float k_ = (1.0f - f) * __expf(-run); kep[t * 512] = (bf16)f2bf(k_); ke[t] = k_;
        }
    }
    const float D = __expf(run);
    Dws[(size_t)unit * 64 + lane] = D;
#pragma unroll
    for (int s8 = 0; s8 < 8; ++s8) { float kd[8];
#pragma unroll
        for (int i = 0; i < 8; ++i) kd[i] = ke[8 * s8 + i] * D;
        *(LAS v4u*)(ldsw + lane * HG_ROW + 16 * s8) = pack8(kd); }
    LDS_WAIT(); asm volatile("" ::: "memory");
    bf16x8 vb[4][2];
#pragma unroll
    for (int nb = 0; nb < 4; ++nb)
#pragma unroll
        for (int ks = 0; ks < 2; ++ks) vb[nb][ks] = *(const LAS bf16x8*)(ldsw + 9216 + (16 * nb + fr) * HG_ROW + (32 * ks + 8 * fq) * 2);
#pragma unroll
    for (int mb = 0; mb < 4; ++mb) {
        bf16x8 ka[2];
#pragma unroll
        for (int ks = 0; ks < 2; ++ks) ka[ks] = *(const LAS bf16x8*)(ldsw + (16 * mb + fr) * HG_ROW + (32 * ks + 8 * fq) * 2);
#pragma unroll
        for (int nb = 0; nb < 4; ++nb) { f32x4 acc = (f32x4){0.f, 0.f, 0.f, 0.f};
            acc = MFMA16(ka[0], vb[nb][0], acc); acc = MFMA16(ka[1], vb[nb][1], acc);
            uint2 o; o.x = pk2(acc[0], acc[1]); o.y = pk2(acc[2], acc[3]);
            *(uint2*)(UT + (size_t)unit * 4096 + (16 * nb + fr) * 64 + 16 * mb + 4 * fq) = o; }
    }
    LDS_WAIT(); asm volatile("" ::: "memory");
}
DI void hgrn_out_unit(const bf16* P, const bf16* QE, const bf16* KE, const bf16* VTg, const bf16* SPT, const float* outg, bf16* CAT, int b, int h, int c, int lane) {
    const int r0 = b * SEQ + 64 * c, unit = (b * 8 + h) * 64 + c, fr = lane & 15, fq = lane >> 4;
    const bf16* qep = QE + (size_t)r0 * 512 + 64 * h; const bf16* kep = KE + (size_t)r0 * 512 + 64 * h;
    const bf16* vtp = VTg + (size_t)unit * 4096; const bf16* spp = SPT + (size_t)unit * 4096;
    bf16x8 spa[4][2], vta[4][2];
#pragma unroll
    for (int mb = 0; mb < 4; ++mb)
#pragma unroll
        for (int ks = 0; ks < 2; ++ks) {
            spa[mb][ks] = *(const bf16x8*)(spp + (16 * mb + fr) * 64 + 32 * ks + 8 * fq);
            const uint2 lo = *(const uint2*)(vtp + (16 * mb + fr) * 64 + 32 * ks + 4 * fq), hi = *(const uint2*)(vtp + (16 * mb + fr) * 64 + 32 * ks + 16 + 4 * fq);
            vta[mb][ks] = __builtin_bit_cast(bf16x8, ((v4u){lo.x, lo.y, hi.x, hi.y}));
        }
    f32x4 og[4];
#pragma unroll
    for (int mb = 0; mb < 4; ++mb) og[mb] = *(const f32x4*)(outg + 16 * mb + 4 * fq);
    bf16x8 qbs[4][2], kas[4][2];
#pragma unroll
    for (int nb = 0; nb < 4; ++nb)
#pragma unroll
        for (int ks = 0; ks < 2; ++ks) { qbs[nb][ks] = *(const bf16x8*)(qep + (size_t)(16 * nb + fr) * 512 + 32 * ks + 8 * fq); kas[nb][ks] = *(const bf16x8*)(kep + (size_t)(16 * nb + fr) * 512 + 32 * ks + 8 * fq); }
#pragma unroll
    for (int nb = 0; nb < 4; ++nb) {
        uint2 hgs[4];
#pragma unroll
        for (int mb = 0; mb < 4; ++mb) hgs[mb] = *(const uint2*)(P + (size_t)(r0 + 16 * nb + fr) * NIN + C_HG + 64 * h + 16 * mb + 4 * fq);
        f32x4 at[4];
#pragma unroll
        for (int sb = 0; sb < 4; ++sb) { at[sb] = (f32x4){0.f, 0.f, 0.f, 0.f};
            if (sb <= nb) {
                at[sb] = MFMA16(kas[sb][0], qbs[nb][0], at[sb]); at[sb] = MFMA16(kas[sb][1], qbs[nb][1], at[sb]);
                if (sb == nb) {
#pragma unroll
                    for (int j = 0; j < 4; ++j) if (4 * fq + j > fr) at[sb][j] = 0.f;
                }
            } }
        bf16x8 bat[2];
#pragma unroll
        for (int p = 0; p < 2; ++p) bat[p] = __builtin_bit_cast(bf16x8, ((v4u){pk2(at[2 * p][0], at[2 * p][1]), pk2(at[2 * p][2], at[2 * p][3]), pk2(at[2 * p + 1][0], at[2 * p + 1][1]), pk2(at[2 * p + 1][2], at[2 * p + 1][3])}));
        f32x4 o[4]; float ss = 0.f;
#pragma unroll
        for (int mb = 0; mb < 4; ++mb) { o[mb] = (f32x4){0.f, 0.f, 0.f, 0.f};
            o[mb] = MFMA16(spa[mb][0], qbs[nb][0], o[mb]); o[mb] = MFMA16(spa[mb][1], qbs[nb][1], o[mb]);
            o[mb] = MFMA16(vta[mb][0], bat[0], o[mb]); if (nb >= 2) o[mb] = MFMA16(vta[mb][1], bat[1], o[mb]);
            ss += (o[mb][0] * o[mb][0] + o[mb][1] * o[mb][1]) + (o[mb][2] * o[mb][2] + o[mb][3] * o[mb][3]); }
        ss += __shfl_xor(ss, 16); ss += __shfl_xor(ss, 32);
        const float r = __builtin_amdgcn_rsqf(ss * (1.0f / 64.0f) + EPS);
        const size_t row = (size_t)(r0 + 16 * nb + fr);
#pragma unroll
        for (int mb = 0; mb < 4; ++mb) {
            const uint2 hgr = hgs[mb];
            const float g0 = __uint_as_float(hgr.x << 16), g1 = __uint_as_float(hgr.x & 0xffff0000u), g2 = __uint_as_float(hgr.y << 16), g3 = __uint_as_float(hgr.y & 0xffff0000u);
            uint2 w; w.x = pk2(o[mb][0] * r * og[mb][0] * silu2_f(g0), o[mb][1] * r * og[mb][1] * silu2_f(g1)); w.y = pk2(o[mb][2] * r * og[mb][2] * silu2_f(g2), o[mb][3] * r * og[mb][3] * silu2_f(g3));
            *(uint2*)(CAT + row * DM + 512 + 64 * h + 16 * mb + 4 * fq) = w; }
    }
}

constexpr int SA_KL = 0, SA_VL = 33280, SA_QL = 66048, SA_SL = 67072, SA_RL = 69120;
DI void attn_sample_unit(LAS unsigned char* lds, const bf16* P, const float* cache_k, const float* cache_v, const float* sinks, float* out, bf16* CAT, int b, int kvh, int tid, int lane, int wave) {
    LAS float* KL = (LAS float*)(lds + SA_KL); LAS float* VL = (LAS float*)(lds + SA_VL); LAS float* QL = (LAS float*)(lds + SA_QL); LAS float* SL = (LAS float*)(lds + SA_SL); LAS float* RL = (LAS float*)(lds + SA_RL);
    const bf16* prow = P + (size_t)(MPROMPT + b) * NIN;
#pragma unroll 4
    for (int i = 0; i < 16; ++i) { const int idx = tid + 512 * i, key = idx >> 6, d = idx & 63; float kv, vv;
        if (key < 127) { const size_t src = ((size_t)(b * 128 + key + 1) * 2 + kvh) * 64 + d; kv = cache_k[src]; vv = cache_v[src]; }
        else { const bf16* hp = prow + C_K + 64 * kvh; kv = d < 16 ? rope_elem(hp, d, PAST_POS) : bf2f(hp[d]); vv = bf2f(prow[C_V + 64 * kvh + d]); }
        KL[key * 65 + d] = kv; VL[key * 64 + d] = vv;
        const size_t dst = ((size_t)(b * 128 + key) * 2 + kvh) * 64 + d; out[O_WKS + dst] = kv; out[O_WVS + dst] = vv; }
    if (tid < 256) { const int g = tid >> 6, d = tid & 63; const bf16* hp = prow + C_Q + 64 * (4 * kvh + g);
        const float q = d < 16 ? rope_elem(hp, d, PAST_POS) : bf2f(hp[d]); QL[g * 64 + d] = q * (0.125f * LOG2E); }
    __syncthreads();
    { const int g = tid >> 7, j = tid & 127; float s = 0.f;
#pragma unroll 16
      for (int d = 0; d < 64; ++d) s += QL[g * 64 + d] * KL[j * 65 + d];
      SL[g * 128 + j] = s; }
    __syncthreads();
    if (wave < 4) { const int g = wave; const float sink2 = sinks[4 * kvh + g] * LOG2E; const float s0 = SL[g * 128 + lane], s1 = SL[g * 128 + 64 + lane];
        const float m = fmaxf(wave_max(fmaxf(s0, s1)), sink2); const float p0 = __builtin_amdgcn_exp2f(s0 - m), p1 = __builtin_amdgcn_exp2f(s1 - m);
        const float sum = wave_sum(p0 + p1) + __builtin_amdgcn_exp2f(sink2 - m); SL[g * 128 + lane] = p0; SL[g * 128 + 64 + lane] = p1; if (lane == 0) RL[g] = 1.0f / sum; }
    __syncthreads();
    if (tid < 256) { const int g = tid >> 6, d = tid & 63; float o = 0.f;
#pragma unroll 16
        for (int j = 0; j < 128; ++j) o += SL[g * 128 + j] * VL[j * 64 + d];
        CAT[(size_t)(MPROMPT + b) * DM + 64 * (4 * kvh + g) + d] = (bf16)f2bf(o * RL[g]); }
    __syncthreads();
}
DI void hgrn_sample_unit(const bf16* P, const float* lbv, const float* state, const float* outg, float* out, bf16* CAT, int b, int h, int lane) {
    const bf16* prow = P + (size_t)(MPROMPT + b) * NIN + 64 * h + lane;
    const float lb = lbv[64 * h + lane];
    const float q = bf2f(prow[C_HQ]) * 0.125f, f = lb + (1.0f - lb) * sigmoid_f(bf2f(prow[C_HF])), kk = 1.0f - f, v = bf2f(prow[C_HI]), hg = bf2f(prow[C_HG]);
    const float* S = state + (size_t)(b * 8 + h) * 4096 + lane; float* So = out + O_SS + (size_t)(b * 8 + h) * 4096 + lane;
    float o = 0.f; float sv[64];
#pragma unroll
    for (int k = 0; k < 64; ++k) sv[k] = S[k * 64];
#pragma unroll
    for (int k = 0; k < 64; ++k) { const float fk = __shfl(f, k), kkk = __shfl(kk, k), qk = __shfl(q, k); const float sn = fk * sv[k] + kkk * v; So[k * 64] = sn; o += qk * sn; }
    const float r = __builtin_amdgcn_rsqf(wave_sum(o * o) * (1.0f / 64.0f) + EPS);
    CAT[(size_t)(MPROMPT + b) * DM + 512 + 64 * h + lane] = (bf16)f2bf(o * r * outg[lane] * silu2_f(hg));
}

#define XB_TMO      128
#define XB_XCNT(j)  (256  + 64 * (j))
#define XB_XSUB(j)  (1280 + 64 * (j))
#define XB_XGEN(j)  (2304 + 64 * (j))
#define XB_TOP      3328
#define XB_TOPGEN   3392
#define XCD_BAR_WORDS 3456
#define XB_SPIN_CAP (1u << 18)

__device__ __forceinline__ unsigned xb_ld(unsigned* p)              { return __hip_atomic_load(p, __ATOMIC_RELAXED, __HIP_MEMORY_SCOPE_AGENT); }
__device__ __forceinline__ unsigned xb_add(unsigned* p, unsigned v) { return __hip_atomic_fetch_add(p, v, __ATOMIC_RELAXED, __HIP_MEMORY_SCOPE_AGENT); }
__device__ __forceinline__ unsigned xb_xcc_id() { return (unsigned)__builtin_amdgcn_s_getreg((3 << 11) | 20) & 0xFu; }
#define XB_SPIN(cond, bar) do { unsigned _sp = 0; while (cond) { __builtin_amdgcn_s_sleep(1); \
    if ((++_sp & 255u) == 0u) { if (xb_ld(&(bar)[XB_TMO])) break; if (_sp > XB_SPIN_CAP) { atomicAdd(&(bar)[XB_TMO], 1u); break; } } } } while (0)

struct XcdBarrier {
    unsigned* bar; unsigned x;
    volatile LAS unsigned* st;
};

__device__ __forceinline__ XcdBarrier xcd_barrier_post(unsigned* bar, volatile LAS unsigned* st) {
    XcdBarrier b; b.bar = bar; b.x = xb_xcc_id(); b.st = st;
    if (threadIdx.x == 0) (void)xb_add(&bar[XB_XCNT(b.x)], 1u);
    return b;
}
__device__ __forceinline__ void xcd_barrier_complete(unsigned* bar, unsigned x, unsigned& nloc, unsigned& nx) {
    const unsigned G = gridDim.x * gridDim.y * gridDim.z;
    unsigned sum, cnt, mine, sp = 0u;
    for (;;) {
        sum = 0u; cnt = 0u; mine = 0u;
#pragma unroll
        for (unsigned j = 0; j < 16; ++j) { const unsigned c = xb_ld(&bar[XB_XCNT(j)]); sum += c; cnt += (c > 0u) ? 1u : 0u; mine = (j == x) ? c : mine; }
        if (sum == G) break;
        __builtin_amdgcn_s_sleep(1);
        if ((++sp & 255u) == 0u) { if (xb_ld(&bar[XB_TMO])) break; if (sp > XB_SPIN_CAP) { atomicAdd(&bar[XB_TMO], 1u); break; } }
    }
    nloc = mine > 0u ? mine : 1u; nx = cnt > 0u ? cnt : 1u;
}

__device__ __forceinline__ void xcd_barrier(const XcdBarrier& b) {
    asm volatile("s_waitcnt vmcnt(0)" ::: "memory");
    __syncthreads();
    if (threadIdx.x == 0) {
        unsigned* bar = b.bar;
        __builtin_amdgcn_s_waitcnt(0);
        unsigned nloc = b.st[0], nx = b.st[1];
        if (nloc == 0u) { xcd_barrier_complete(bar, b.x, nloc, nx); b.st[0] = nloc; b.st[1] = nx; }
        const unsigned old = xb_add(&bar[XB_XSUB(b.x)], 1u);
        const unsigned gen = old / nloc;
        if (old + 1u == (gen + 1u) * nloc) {
            __builtin_amdgcn_fence(__ATOMIC_RELEASE, "agent");
            asm volatile("s_waitcnt vmcnt(0)" ::: "memory");
            const unsigned og = xb_add(&bar[XB_TOP], 1u);
            const unsigned tg = og / nx;
            if (og + 1u == (tg + 1u) * nx) xb_add(&bar[XB_TOPGEN], 1u);
            else XB_SPIN(xb_ld(&bar[XB_TOPGEN]) == tg, bar);
            __builtin_amdgcn_fence(__ATOMIC_ACQUIRE, "agent");
            xb_add(&bar[XB_XGEN(b.x)], 1u);
            asm volatile("s_waitcnt vmcnt(0)" ::: "memory");
        } else {
            XB_SPIN(xb_ld(&bar[XB_XGEN(b.x)]) == gen, bar);
            __builtin_amdgcn_fence(__ATOMIC_ACQUIRE, "agent");
            asm volatile("s_waitcnt vmcnt(0)" ::: "memory");
        }
    }
    __syncthreads();
}

struct Args { const float* in[20]; float* out; unsigned char* ws; };
__global__ void __launch_bounds__(512, 2) mk_fwd(Args args) {
    extern __shared__ __attribute__((aligned(16))) unsigned char lds_raw[];
    cg::grid_group grid = cg::this_grid();
    LAS unsigned char* lds = (LAS unsigned char*)lds_raw;
    const int tid = threadIdx.x, lane = tid & 63, wave = __builtin_amdgcn_readfirstlane(tid >> 6);
    const int G = gridDim.x, bid = blockIdx.x, gw = bid * 8 + wave, NGW = G * 8;
    unsigned char* ws = args.ws; float* out = args.out;
    const float* x_prompt = args.in[0]; const float* x_sample = args.in[1];
    bf16* Wgu1 = (bf16*)(ws + WS_WGU1); bf16* Wdn1 = (bf16*)(ws + WS_WDN1); bf16* Win = (bf16*)(ws + WS_WIN); bf16* Wout = (bf16*)(ws + WS_WOUT);
    bf16* Wgu2 = (bf16*)(ws + WS_WGU2); bf16* Wdn2 = (bf16*)(ws + WS_WDN2);
    float* LBV = (float*)(ws + WS_LB); bf16* XA = (bf16*)(ws + WS_XA); bf16* ACT = (bf16*)(ws + WS_ACT); bf16* Y = (bf16*)(ws + WS_Y); bf16* CATB = (bf16*)(ws + WS_CAT);
    float* YS = (float*)(ws + WS_YS); float* RS = (float*)(ws + WS_RS);
    bf16* QE = (bf16*)(ws + WS_QE); bf16* KE = (bf16*)(ws + WS_KE); bf16* VTg = (bf16*)(ws + WS_VT); bf16* UT = (bf16*)(ws + WS_UT); float* Dws = (float*)(ws + WS_D);
    if (tid < 4) ((volatile LAS unsigned*)(lds + LDS_BARW))[tid] = 0u;
    __syncthreads();
    const XcdBarrier xbar = xcd_barrier_post((unsigned*)ws, (volatile LAS unsigned*)(lds + LDS_BARW));
    if (ws == nullptr) grid.sync();
    for (int rep = 0; rep < REP_P0; ++rep) {
        LAS float* scr = (LAS float*)(lds + wave * 16640);
        constexpr int I_GU = 16 * 88, I_DN = 44 * 16, I_IN = 16 * 44, I_OUT = 16 * 16, NITEMS = 2 * I_GU + 2 * I_DN + I_IN + I_OUT, NROWG = MPAD / 4;
        for (int it = gw; it < NITEMS + NROWG; it += NGW) {
            int r = it;
            if (r < I_GU) { tr_item64<1>(args.in[7], DM, NGU, args.in[5], Wgu1, scr, r, lane); continue; } r -= I_GU;
            if (r < I_GU) { tr_item64<1>(args.in[18], DM, NGU, args.in[16], Wgu2, scr, r, lane); continue; } r -= I_GU;
            if (r < I_DN) { tr_item64<0>(args.in[8], DFF, DM, nullptr, Wdn1, scr, r, lane); continue; } r -= I_DN;
            if (r < I_DN) { tr_item64<0>(args.in[19], DFF, DM, nullptr, Wdn2, scr, r, lane); continue; } r -= I_DN;
            if (r < I_IN) { tr_item64<0>(args.in[11], DM, NIN, args.in[9], Win, scr, r, lane); continue; } r -= I_IN;
            if (r < I_OUT) { tr_item64<0>(args.in[15], DM, DM, nullptr, Wout, scr, r, lane); continue; } r -= I_OUT;
            cvt_rows<4>(x_prompt, x_sample, XA, RS, 4 * r, 1, lane);
        }
        if (bid == 0) { const float* l = args.in[13]; LBV[tid] = 1.0f / (1.0f + __expf(l[512 + tid] - l[tid])); }
        for (int e = bid * 512 + tid; e < MSAMP * DM / 4; e += G * 512) ((f32x4*)YS)[e] = (f32x4){0.f, 0.f, 0.f, 0.f};
    }
    xcd_barrier(xbar);
    { pg8::Gemm g{XA, Wgu1, MPAD, NGU, DM, DM}; pg8::StaticOrder S; S.init(MPAD, NGU, G, bid); pg8::EpiSwiGLU E{ACT, DFF, RS};
      pg8::gemm_phase<pg8::EpiSwiGLU, pg8::StaticOrder, true, true>(lds, g, S, E); }
    xcd_barrier(xbar);
    { pg8::Gemm g{ACT, Wdn1, MPROMPT, DM, DFF, DFF}; pg8::StaticOrder S; S.init(MPROMPT, DM, G, bid); pg8::EpiBf16 E{Y, DM, nullptr};
      pg8::gemm_phase<pg8::EpiBf16, pg8::StaticOrder, true, true>(lds, g, S, E);
      pg8::Gemm gt{ACT, Wdn1, MPAD, DM, 256, DFF}; pg8::TailOrder T{MPROMPT / 256, 4, 44, 256, (G - 1) - bid}; pg8::EpiAtomicF32 Et{YS - (size_t)MPROMPT * DM, DM};
      pg8::gemm_phase<pg8::EpiAtomicF32, pg8::TailOrder, false, true>(lds, gt, T, Et); }
    xcd_barrier(xbar);
    for (int m0 = gw; m0 < MTOK; m0 += 4 * NGW) resid_rows<false, false, 4>(x_prompt, x_sample, XA, Y, YS, args.in[6], 0.5f, out, XA, RS, m0, NGW, lane);
    xcd_barrier(xbar);
    { pg8::Gemm g{XA, Win, MPAD, NIN, DM, DM}; pg8::StaticOrder S; S.init(MPAD, NIN, G, bid); pg8::EpiBf16 E{ACT, NIN, RS};
      pg8::gemm_phase<pg8::EpiBf16, pg8::StaticOrder, true, true>(lds, g, S, E); }
    xcd_barrier(xbar);
    for (int rep = 0; rep < REP_MIX; ++rep) {
    {
        const bf16* P = ACT; bf16* CAT = CATB;
        for (int u = bid; u < 256; u += G) attn_prompt_unit(lds, P, CAT, args.in[12], u >> 6, (u >> 1) & 31, u & 1, tid, lane, wave);
        for (int u = gw; u < 2048; u += NGW) hgrn_gate_unit(lds + wave * HG_WAVE_LDS, P, LBV, QE, KE, VTg, UT, Dws, u >> 9, (u >> 6) & 7, u & 63, lane);
        __syncthreads();
        for (int u = bid; u < 256; u += G) attn_sample_unit(lds, P, args.in[2], args.in[3], args.in[12], out, CAT, u >> 1, u & 1, tid, lane, wave);
        for (int u = gw; u < 1024; u += NGW) hgrn_sample_unit(P, LBV, args.in[4], args.in[14], out, CAT, u >> 3, u & 7, lane);
        for (int e = bid * 512 + tid; e < 131072; e += G * 512) {
            const int which = e >> 16, r = e & 65535, b = r >> 14, j = (r >> 7) & 127, kvh = (r >> 6) & 1, d = r & 63;
            const bf16* prow = P + (size_t)(b * SEQ + SEQ - 128 + j) * NIN;
            float v;
            if (which == 0) { const bf16* hp = prow + C_K + 64 * kvh; v = d < 16 ? rope_elem(hp, d, (float)(SEQ - 128 + j)) : bf2f(hp[d]); }
            else v = bf2f(prow[C_V + 64 * kvh + d]);
            out[O_WKP + e] = v;
        }
    }
    xcd_barrier(xbar);
    for (int e = bid * 512 + tid; e < 65536; e += G * 512) {
        const int bh = e >> 11, pr = e & 2047, k0 = (2 * pr) & 63, dv = (2 * pr) >> 6; float S0 = 0.f, S1 = 0.f;
        unsigned* up = (unsigned*)(UT + (size_t)bh * 64 * 4096) + pr; const float* dp = Dws + (size_t)bh * 64 * 64 + k0;
#pragma unroll 1
        for (int c0 = 0; c0 < 64; c0 += 32) { unsigned raw[32]; float2 dd[32];
#pragma unroll
            for (int c = 0; c < 32; ++c) { raw[c] = up[(size_t)(c0 + c) * 2048]; dd[c] = *(const float2*)(dp + (c0 + c) * 64); }
#pragma unroll
            for (int c = 0; c < 32; ++c) { up[(size_t)(c0 + c) * 2048] = pk2(S0, S1); S0 = dd[c].x * S0 + __uint_as_float(raw[c] << 16); S1 = dd[c].y * S1 + __uint_as_float(raw[c] & 0xffff0000u); } }
        out[O_SP + (size_t)bh * 4096 + k0 * 64 + dv] = S0; out[O_SP + (size_t)bh * 4096 + (k0 + 1) * 64 + dv] = S1;
    }
    xcd_barrier(xbar);
    {
        const bf16* P = ACT; bf16* CAT = CATB;
        for (int u = gw; u < 2048; u += NGW) hgrn_out_unit(P, QE, KE, VTg, UT, args.in[14], CAT, u >> 9, (u >> 6) & 7, u & 63, lane);
    }
    xcd_barrier(xbar);
    }
    { pg8::Gemm g{CATB, Wout, MPROMPT, DM, DM, DM}; pg8::StaticOrder S; S.init(MPROMPT, DM, G, bid); pg8::EpiBf16 E{Y, DM, nullptr};
      pg8::gemm_phase<pg8::EpiBf16, pg8::StaticOrder, true, true>(lds, g, S, E);
      pg8::Gemm gt{CATB, Wout, MPAD, DM, 128, DM}; pg8::TailOrder T{MPROMPT / 256, 4, 32, 128, (G - 1) - bid}; pg8::EpiAtomicF32 Et{YS - (size_t)MPROMPT * DM, DM};
      pg8::gemm_phase<pg8::EpiAtomicF32, pg8::TailOrder, false, true>(lds, gt, T, Et); }
    xcd_barrier(xbar);
    for (int m0 = gw; m0 < MTOK; m0 += 4 * NGW) resid_rows<true, false, 4>(x_prompt, x_sample, XA, Y, YS, args.in[10], 1.0f, out, XA, RS, m0, NGW, lane);
    xcd_barrier(xbar);
    { pg8::Gemm g{XA, Wgu2, MPAD, NGU, DM, DM}; pg8::StaticOrder S; S.init(MPAD, NGU, G, bid); pg8::EpiSwiGLU E{ACT, DFF, RS};
      pg8::gemm_phase<pg8::EpiSwiGLU, pg8::StaticOrder, true, true>(lds, g, S, E); }
    xcd_barrier(xbar);
    { pg8::Gemm g{ACT, Wdn2, MPROMPT, DM, DFF, DFF}; pg8::StaticOrder S; S.init(MPROMPT, DM, G, bid); pg8::EpiBf16 E{Y, DM, nullptr};
      pg8::gemm_phase<pg8::EpiBf16, pg8::StaticOrder, true, true>(lds, g, S, E);
      pg8::Gemm gt{ACT, Wdn2, MPAD, DM, 256, DFF}; pg8::TailOrder T{MPROMPT / 256, 4, 44, 256, (G - 1) - bid}; pg8::EpiAtomicF32 Et{YS - (size_t)MPROMPT * DM, DM};
      pg8::gemm_phase<pg8::EpiAtomicF32, pg8::TailOrder, false, true>(lds, gt, T, Et); }
    xcd_barrier(xbar);
    for (int m0 = gw; m0 < MTOK; m0 += 4 * NGW) resid_rows<true, true, 4>(x_prompt, x_sample, XA, Y, YS, args.in[17], 0.5f, out, XA, RS, m0, NGW, lane);
}

extern "C" void kernel_launch(void* const* d_in, const int* in_sizes, int n_in, void* d_out, int out_size, void* d_ws, size_t ws_size, hipStream_t stream) {
    static int grid = 0;
    if (grid == 0) {
        int dev = 0, cus = 0, per_cu = 0;
        (void)hipGetDevice(&dev);
        (void)hipDeviceGetAttribute(&cus, hipDeviceAttributeMultiprocessorCount, dev);
        (void)hipFuncSetAttribute((const void*)mk_fwd, hipFuncAttributeMaxDynamicSharedMemorySize, LDS_BYTES);
        if (hipOccupancyMaxActiveBlocksPerMultiprocessor(&per_cu, (const void*)mk_fwd, 512, LDS_BYTES) != hipSuccess || per_cu < 1) { fprintf(stderr, "occupancy query: %d blocks per CU\n", per_cu); per_cu = 1; }
        (void)hipGetLastError();
        grid = cus * (per_cu > 1 ? 1 : per_cu);
        if (n_in != 20 || ws_size < WS_END) { fprintf(stderr, "kernel_launch: unexpected inputs (n_in %d, ws %zu)\n", n_in, ws_size); grid = -1; }
    }
    if (grid < 0) return;
    if (hipMemsetAsync(d_ws, 0, XCD_BAR_WORDS * 4, stream) != hipSuccess) { fprintf(stderr, "kernel_launch: memset of the barrier words failed\n"); return; }
    Args a{};
    for (int i = 0; i < 20; ++i) a.in[i] = (const float*)d_in[i];
    a.out = (float*)d_out; a.ws = (unsigned char*)d_ws;
    void* kargs[] = {&a};
    hipError_t e = hipLaunchCooperativeKernel((const void*)mk_fwd, dim3(grid), dim3(512), kargs, LDS_BYTES, stream);
    if (e != hipSuccess) fprintf(stderr, "cooperative launch failed: %s (grid %d)\n", hipGetErrorString(e), grid);
}
```

```cpp
#include <hip/hip_runtime.h>
#include <hip/hip_cooperative_groups.h>
#include <cstdio>
#include <cstdint>
namespace cg = cooperative_groups;
#ifndef REP_P0
#define REP_P0 1
#endif
#ifndef REP_MIX
#define REP_MIX 1
#endif
#ifndef REP_P3
#define REP_P3 1
#endif
namespace pg8 {
#define PG8_LAS __attribute__((address_space(3)))
typedef unsigned short bf16_t;
typedef short bf16x8 __attribute__((ext_vector_type(8)));
typedef float f32x4 __attribute__((ext_vector_type(4)));
typedef unsigned u32x4 __attribute__((ext_vector_type(4)));
constexpr int BM = 256, BK = 64, HALF = 128, HTB = HALF * BK * 2  , STAGE_BYTES = 8 * HTB, NXCD = 8, WGM = 8;

__host__ __device__ __forceinline__ int lds_byte(int r, int c) { const int st = (r >> 4) * 2 + (c >> 5), rr = r & 15, cc = c & 31, ob = rr * 64 + cc * 2; return st * 1024 + (ob ^ (((ob >> 9) & 1) << 5)); }
__host__ __device__ __forceinline__ void stage_rc(int b, int& R, int& C) { const int st = b / 1024, sb = b % 1024, swz = sb ^ (((sb >> 9) & 1) << 5); R = (st >> 1) * 16 + swz / 64; C = (st & 1) * 32 + (swz % 64) / 2; }
__host__ __device__ __forceinline__ int perm32(int rho) { const int n = rho >> 4, i = rho & 15; return 8 * (i >> 2) + 4 * n + (i & 3); }

struct Unit { int pm, pn, k0; };
struct Gemm { const bf16_t* A; const bf16_t* Bt; int M, N, K, ld; };

struct StaticOrder {
    int nM, nN, nwg, G, c;
    __host__ __device__ void init(int M, int N, int G_, int c_) { nM = M / BM; nN = N / BM; nwg = nM * nN; G = G_; c = c_; }
    __host__ __device__ bool next(int i, Unit& u) const {
        const long L = (long)i * G + c; if (L >= nwg) return false;
        int wgid = (int)L; { const int q = nwg / NXCD, r = nwg % NXCD, xcd = wgid % NXCD, off = wgid / NXCD; wgid = (xcd < r ? xcd * (q + 1) : r * (q + 1) + (xcd - r) * q) + off; }
        const int nig = WGM * nN, gid = wgid / nig, fm = gid * WGM, gsz = (nM - fm) < WGM ? (nM - fm) : WGM;
        u.pm = fm + ((wgid % nig) % gsz); u.pn = (wgid % nig) / gsz; u.k0 = 0; return true;
    }
    __device__ __forceinline__ void a_ready(const Unit&) const {}
    __device__ __forceinline__ void done(const Unit&) const {}
};

__device__ __forceinline__ unsigned cvt_pk_bf16(float lo, float hi) { unsigned r; asm volatile("v_cvt_pk_bf16_f32 %0, %1, %2" : "=v"(r) : "v"(lo), "v"(hi)); return r; }
typedef float f32x2 __attribute__((ext_vector_type(2)));
struct EpiBf16 {
    static constexpr bool PERM = true, AFTER_DRAIN = false;
    bf16_t* O; int ldc; const float* rs;
    __device__ __forceinline__ void operator()(const f32x4 (&acc)[2][2][4][2], const Unit& u, int wr, int wc, int fr, int fq) const {
        const int row0 = u.pm * BM + wr * 64 + fr; const int col0 = u.pn * BM + wc * 32 + 8 * fq;
#pragma unroll
        for (int ai = 0; ai < 2; ++ai)
#pragma unroll
            for (int m = 0; m < 4; ++m) { const int row = row0 + ai * HALF + m * 16; bf16_t* rowp = O + (size_t)row * ldc + col0; const float r = rs ? rs[row] : 1.0f;
#pragma unroll
                for (int bj = 0; bj < 2; ++bj) { const f32x4 v0 = acc[ai][bj][m][0] * r, v1 = acc[ai][bj][m][1] * r;
                    u32x4 w; w.x = cvt_pk_bf16(v0[0], v0[1]); w.y = cvt_pk_bf16(v0[2], v0[3]); w.z = cvt_pk_bf16(v1[0], v1[1]); w.w = cvt_pk_bf16(v1[2], v1[3]);
                    *(u32x4*)(rowp + bj * HALF) = w; } }
    }
};
__device__ __forceinline__ float silu_f(float g) { return g * __builtin_amdgcn_rcpf(1.0f + __expf(-g)); }
struct EpiSwiGLU {
    static constexpr bool PERM = true, AFTER_DRAIN = false;
    bf16_t* O; int ldc; const float* rs;
    __device__ __forceinline__ void operator()(const f32x4 (&acc)[2][2][4][2], const Unit& u, int wr, int wc, int fr, int fq) const {
        const int row0 = u.pm * BM + wr * 64 + fr; const int col0 = u.pn * HALF + wc * 32 + 8 * fq;
#pragma unroll
        for (int ai = 0; ai < 2; ++ai)
#pragma unroll
            for (int m = 0; m < 4; ++m) { const int row = row0 + ai * HALF + m * 16; bf16_t* rowp = O + (size_t)row * ldc + col0; const float r = rs[row];
                const f32x4 g0 = acc[ai][0][m][0] * r, g1 = acc[ai][0][m][1] * r, u0 = acc[ai][1][m][0] * r, u1 = acc[ai][1][m][1] * r;
                u32x4 w;
                w.x = cvt_pk_bf16(silu_f(g0[0]) * u0[0], silu_f(g0[1]) * u0[1]); w.y = cvt_pk_bf16(silu_f(g0[2]) * u0[2], silu_f(g0[3]) * u0[3]);
                w.z = cvt_pk_bf16(silu_f(g1[0]) * u1[0], silu_f(g1[1]) * u1[1]); w.w = cvt_pk_bf16(silu_f(g1[2]) * u1[2], silu_f(g1[3]) * u1[3]);
                *(u32x4*)rowp = w; }
    }
};
struct EpiF32 {
    static constexpr bool PERM = false, AFTER_DRAIN = false;
    float* O; int ldc;
    __device__ __forceinline__ void operator()(const f32x4 (&acc)[2][2][4][2], const Unit& u, int wr, int wc, int fr, int fq) const {
        const int row0 = u.pm * BM + wr * 64 + fr; const int col0 = u.pn * BM + wc * 32 + 4 * fq;
#pragma unroll
        for (int ai = 0; ai < 2; ++ai)
#pragma unroll
            for (int m = 0; m < 4; ++m) { float* rowp = O + (size_t)(row0 + ai * HALF + m * 16) * ldc + col0;
#pragma unroll
                for (int bj = 0; bj < 2; ++bj)
#pragma unroll
                    for (int n = 0; n < 2; ++n) *(f32x4*)(rowp + bj * HALF + n * 16) = acc[ai][bj][m][n]; }
    }
};
struct TailOrder {
    int pm, nN, nunits, kc, c;
    __device__ bool next(int i, Unit& u) const { if (i != 0 || c >= nunits) return false; u.pm = pm; u.pn = c % nN; u.k0 = (c / nN) * kc; return true; }
    __device__ __forceinline__ void a_ready(const Unit&) const {}
    __device__ __forceinline__ void done(const Unit&) const {}
};
struct EpiPartF32 {
    static constexpr bool PERM = false, AFTER_DRAIN = false;
    float* O; int ldc, kc;
    __device__ __forceinline__ void operator()(const f32x4 (&acc)[2][2][4][2], const Unit& u, int wr, int wc, int fr, int fq) const {
        int t_ = threadIdx.x; asm volatile("" : "+v"(t_));
        const int fr_ = t_ & 15, fq_ = (t_ >> 4) & 3;
        const int row0 = wr * 64 + fr_; const int col0 = u.pn * BM + wc * 32 + 4 * fq_;
        float* base = O + (size_t)(u.k0 / kc) * (128 * ldc);
#pragma unroll
        for (int m = 0; m < 4; ++m) { float* rowp = base + (size_t)(row0 + m * 16) * ldc + col0;
#pragma unroll
            for (int bj = 0; bj < 2; ++bj)
#pragma unroll
                for (int n = 0; n < 2; ++n) *(f32x4*)(rowp + bj * HALF + n * 16) = acc[0][bj][m][n]; }
    }
};
template <class Epi, class Sched, bool ALIGN_EPI = false, bool SP2 = false>
__device__ __forceinline__ void gemm_phase(PG8_LAS unsigned char* lds, const Gemm g, const Sched& S, const Epi& E) {
    int tid = threadIdx.x; asm volatile("" : "+v"(tid));
    const int wid = __builtin_amdgcn_readfirstlane(tid >> 6), lane = tid & 63, wr = wid >> 2, wc = wid & 3, fr = lane & 15, fq = lane >> 4;
    const int K = g.ld, nt = g.K / BK;
    unsigned voffA[2], voffB[2];
#pragma unroll
    for (int i = 0; i < 2; ++i) { int R, C; stage_rc(tid * 16 + i * 8192, R, C); const int Rb = Epi::PERM ? ((R & ~31) + perm32(R & 31)) : R;
        voffA[i] = (unsigned)(R * K + C) * 2u; voffB[i] = (unsigned)(Rb * K + C) * 2u; }
    const size_t kstep = (size_t)(BK * 2);
    const size_t hstep = (size_t)HALF * K * 2;
    const size_t tstep = 2 * hstep;
    const unsigned ldsw = (unsigned)wid * 1024u;
    const int aoff = lds_byte(wr * 64 + fr, fq * 8), boff = lds_byte(wc * 32 + fr, fq * 8);
#define PG8_SA(b, h) (((b) * 2 + (h)) * HTB)
#define PG8_SB(b, h) ((4 + (b) * 2 + (h)) * HTB)
#define PG8_STAGE(bufoff, gbase, voff) do { _Pragma("unroll") for (int _i = 0; _i < 2; ++_i) \
        __builtin_amdgcn_global_load_lds((const unsigned*)((const char*)(gbase) + (voff)[_i]), (PG8_LAS unsigned*)(lds + (bufoff) + ldsw + _i * 8192), 16, 0, 0); } while (0)
#define PG8_LDA(dst, b, h) do { _Pragma("unroll") for (int m = 0; m < 4; ++m) _Pragma("unroll") for (int k = 0; k < 2; ++k) dst[m][k] = *(const PG8_LAS bf16x8*)(lds + PG8_SA(b, h) + aoff + m * 2048 + k * 1024); } while (0)
#define PG8_LDB(dst, b, h) do { _Pragma("unroll") for (int n = 0; n < 2; ++n) _Pragma("unroll") for (int k = 0; k < 2; ++k) dst[n][k] = *(const PG8_LAS bf16x8*)(lds + PG8_SB(b, h) + boff + n * 2048 + k * 1024); } while (0)
#define PG8_MMA(ai, bj, At, Bt) do { __builtin_amdgcn_s_setprio(1); _Pragma("unroll") for (int m = 0; m < 4; ++m) _Pragma("unroll") for (int n = 0; n < 2; ++n) _Pragma("unroll") for (int k = 0; k < 2; ++k) \
        acc[ai][bj][m][n] = __builtin_amdgcn_mfma_f32_16x16x32_bf16(Bt[n][k], At[m][k], acc[ai][bj][m][n], 0, 0, 0); __builtin_amdgcn_s_setprio(0); } while (0)
#define PG8_WAIT_V(n) asm volatile("s_waitcnt vmcnt(" #n ")" ::: "memory")
#define PG8_WAIT_L(n) asm volatile("s_waitcnt lgkmcnt(" #n ")" ::: "memory")
#define PG8_BAR __builtin_amdgcn_s_barrier()
#define PG8_SCHED __builtin_amdgcn_sched_barrier(0)
    Unit cur, nxt; int ui = 0;
    if (!S.next(0, cur)) return;
    f32x4 acc[2][2][4][2];
#pragma unroll
    for (int a = 0; a < 2; ++a)
#pragma unroll
        for (int b = 0; b < 2; ++b)
#pragma unroll
            for (int m = 0; m < 4; ++m)
#pragma unroll
                for (int n = 0; n < 2; ++n) acc[a][b][m][n] = (f32x4){0.f, 0.f, 0.f, 0.f};
    bf16x8 At[4][2], B0[2][2], B1[2][2];
    const char* cA = (const char*)g.A + (size_t)cur.pm * tstep + (size_t)cur.k0 * 2; const char* cB = (const char*)g.Bt + (size_t)cur.pn * tstep + (size_t)cur.k0 * 2;
    S.a_ready(cur);
    if constexpr (SP2) {
        PG8_STAGE(PG8_SB(0, 0), cB, voffB); PG8_STAGE(PG8_SB(0, 1), cB + hstep, voffB); PG8_STAGE(PG8_SA(0, 0), cA, voffA); PG8_STAGE(PG8_SA(0, 1), cA + hstep, voffA);
        if (wr == 1) PG8_BAR;
        PG8_WAIT_V(2); PG8_BAR;
        PG8_STAGE(PG8_SB(1, 0), cB + kstep, voffB); PG8_STAGE(PG8_SA(1, 0), cA + kstep, voffA); PG8_STAGE(PG8_SB(1, 1), cB + hstep + kstep, voffB);
        PG8_WAIT_V(6); PG8_BAR;
    } else {
        PG8_STAGE(PG8_SB(0, 0), cB, voffB); PG8_STAGE(PG8_SA(0, 0), cA, voffA); PG8_STAGE(PG8_SB(0, 1), cB + hstep, voffB); PG8_STAGE(PG8_SA(0, 1), cA + hstep, voffA);
        if (wr == 1) PG8_BAR;
        PG8_WAIT_V(4); PG8_BAR;
        PG8_STAGE(PG8_SB(1, 0), cB + kstep, voffB); PG8_STAGE(PG8_SA(1, 0), cA + kstep, voffA); PG8_STAGE(PG8_SB(1, 1), cB + hstep + kstep, voffB);
        PG8_WAIT_V(6); PG8_BAR;
    }
    for (;;) {
        const bool has_next = S.next(ui + 1, nxt);
        const char* nA = has_next ? (const char*)g.A + (size_t)nxt.pm * tstep + (size_t)nxt.k0 * 2 : cA; const char* nB = has_next ? (const char*)g.Bt + (size_t)nxt.pn * tstep + (size_t)nxt.k0 * 2 : cB;
        for (int t = 0; t < nt; t += 2) {
            const bool last = (t == nt - 2);
            const char* a1 = cA + (size_t)(t + 1) * kstep;
            const char* a2 = last ? nA : cA + (size_t)(t + 2) * kstep; const char* b2 = last ? nB : cB + (size_t)(t + 2) * kstep;
            const char* a3 = a2 + kstep; const char* b3 = b2 + kstep;
            if (last && has_next) S.a_ready(nxt);
            if constexpr (SP2) {
            PG8_LDB(B0, 0, 0); PG8_LDB(B1, 0, 1); PG8_SCHED; PG8_LDA(At, 0, 0); PG8_STAGE(PG8_SA(1, 1), a1 + hstep, voffA);
            PG8_WAIT_V(8); PG8_WAIT_L(0); PG8_BAR; PG8_MMA(0, 0, At, B0); PG8_MMA(0, 1, At, B1); PG8_BAR; PG8_SCHED;
            PG8_LDA(At, 0, 1); PG8_STAGE(PG8_SB(0, 0), b2, voffB); PG8_STAGE(PG8_SB(0, 1), b2 + hstep, voffB); PG8_STAGE(PG8_SA(0, 0), a2, voffA);
            PG8_WAIT_V(8); PG8_WAIT_L(0); PG8_BAR; PG8_MMA(1, 0, At, B0); PG8_MMA(1, 1, At, B1); PG8_BAR; PG8_SCHED;
            PG8_LDB(B0, 1, 0); PG8_LDB(B1, 1, 1); PG8_SCHED; PG8_LDA(At, 1, 0); PG8_STAGE(PG8_SA(0, 1), a2 + hstep, voffA);
            PG8_WAIT_V(8); PG8_WAIT_L(0); PG8_BAR; PG8_MMA(0, 0, At, B0); PG8_MMA(0, 1, At, B1); PG8_BAR; PG8_SCHED;
            PG8_LDA(At, 1, 1); PG8_STAGE(PG8_SB(1, 0), b3, voffB); PG8_STAGE(PG8_SB(1, 1), b3 + hstep, voffB); PG8_STAGE(PG8_SA(1, 0), a3, voffA);
            PG8_WAIT_V(8); PG8_WAIT_L(0); PG8_BAR; PG8_MMA(1, 0, At, B0); PG8_MMA(1, 1, At, B1); PG8_BAR; PG8_SCHED;
            } else {
            PG8_LDB(B0, 0, 0); PG8_SCHED; PG8_LDA(At, 0, 0); PG8_STAGE(PG8_SA(1, 1), a1 + hstep, voffA);
            PG8_WAIT_L(8); PG8_BAR; PG8_WAIT_L(0); PG8_MMA(0, 0, At, B0); PG8_BAR; PG8_SCHED;
            PG8_LDB(B1, 0, 1); PG8_STAGE(PG8_SB(0, 0), b2, voffB);
            PG8_BAR; PG8_WAIT_L(0); PG8_MMA(0, 1, At, B1); PG8_BAR;
            PG8_LDA(At, 0, 1); PG8_STAGE(PG8_SA(0, 0), a2, voffA);
            PG8_BAR; PG8_WAIT_L(0); PG8_MMA(1, 0, At, B0); PG8_BAR; PG8_SCHED;
            PG8_STAGE(PG8_SB(0, 1), b2 + hstep, voffB);
            PG8_WAIT_V(6); PG8_BAR; PG8_MMA(1, 1, At, B1); PG8_BAR;
            PG8_LDB(B0, 1, 0); PG8_SCHED; PG8_LDA(At, 1, 0); PG8_STAGE(PG8_SA(0, 1), a2 + hstep, voffA);
            PG8_WAIT_L(8); PG8_BAR; PG8_WAIT_L(0); PG8_MMA(0, 0, At, B0); PG8_BAR; PG8_SCHED;
            PG8_LDB(B1, 1, 1); PG8_STAGE(PG8_SB(1, 0), b3, voffB);
            PG8_BAR; PG8_WAIT_L(0); PG8_MMA(0, 1, At, B1); PG8_BAR;
            PG8_LDA(At, 1, 1); PG8_STAGE(PG8_SA(1, 0), a3, voffA);
            PG8_BAR; PG8_WAIT_L(0); PG8_MMA(1, 0, At, B0); PG8_BAR; PG8_SCHED;
            PG8_STAGE(PG8_SB(1, 1), b3 + hstep, voffB);
            PG8_WAIT_V(6); PG8_BAR; PG8_MMA(1, 1, At, B1); PG8_BAR;
            }
        }
        if constexpr (ALIGN_EPI) { if (wr == 0) PG8_BAR; }
        if constexpr (!Epi::AFTER_DRAIN) { E(acc, cur, wr, wc, fr, fq); S.done(cur); }
        if (!has_next) break;
#pragma unroll
        for (int a = 0; a < 2; ++a)
#pragma unroll
            for (int b = 0; b < 2; ++b)
#pragma unroll
                for (int m = 0; m < 4; ++m)
#pragma unroll
                    for (int n = 0; n < 2; ++n) acc[a][b][m][n] = (f32x4){0.f, 0.f, 0.f, 0.f};
        cur = nxt; cA = nA; cB = nB; ++ui;
        if constexpr (ALIGN_EPI) { if (wr == 1) PG8_BAR; }
    }
    PG8_WAIT_V(0);
    if constexpr (!ALIGN_EPI) { if (wr == 0) PG8_BAR; }
    PG8_BAR;
    if constexpr (Epi::AFTER_DRAIN) { E.fused(acc, cur, wr, wc, fr, fq, lds, wid, lane); S.done(cur); }
#undef PG8_SA
#undef PG8_SB
#undef PG8_STAGE
#undef PG8_LDA
#undef PG8_LDB
#undef PG8_MMA
#undef PG8_WAIT_V
#undef PG8_WAIT_L
#undef PG8_BAR
#undef PG8_SCHED
}
}

constexpr int DM = 1024, SEQ = 4096, NBATCH = 4, MPROMPT = 16384, MSAMP = 128, MTOK = 16512, MPAD = 16640, DFF = 2816, NGU = 5632, NIN = 2816;
constexpr int C_Q = 0, C_K = 512, C_V = 640, C_HQ = 768, C_HF = 1280, C_HI = 1792, C_HG = 2304;
constexpr float EPS = 1e-6f;
constexpr float LOG2E = 1.4426950408889634f;
constexpr float PAST_POS = 8192.0f;
constexpr size_t O_WKP = (size_t)MTOK * DM, O_WVP = O_WKP + 65536, O_SP = O_WVP + 65536, O_WKS = O_SP + 131072, O_WVS = O_WKS + 2097152, O_SS = O_WVS + 2097152;
constexpr size_t MiB = 1u << 20;
constexpr size_t WS_WGU1 = 1 * MiB, WS_WDN1 = 12 * MiB, WS_WIN = 18 * MiB, WS_WOUT = 24 * MiB, WS_WGU2 = 26 * MiB, WS_WDN2 = 37 * MiB;
constexpr size_t WS_YS = MiB / 2;
constexpr size_t WS_LB = 43 * MiB;
constexpr size_t WS_D = WS_LB + 65536;
constexpr size_t WS_RS = WS_LB + 655360;
constexpr size_t WS_XA = 44 * MiB;
constexpr size_t WS_ACT = 77 * MiB;
constexpr size_t WS_CAT = 167 * MiB;
constexpr size_t WS_Y = 200 * MiB;
constexpr size_t WS_QE = 200 * MiB, WS_KE = 216 * MiB, WS_VT = 232 * MiB, WS_UT = 1 * MiB;
constexpr size_t WS_YSP = 248 * MiB;
constexpr size_t WS_END = 254 * MiB;
static_assert(WS_XA + (size_t)MPAD * DM * 2 <= WS_ACT && WS_ACT + (size_t)MPAD * DFF * 2 <= WS_CAT && WS_CAT + (size_t)MPAD * DM * 2 <= WS_Y && WS_Y + (size_t)MPROMPT * DM * 2 <= WS_VT && WS_RS + MPAD * 4 <= WS_XA, "ws map");

constexpr int LDS_BYTES = 148480;
constexpr int LDS_BARW = 147456;

#define GAS __attribute__((address_space(1)))
#define LAS __attribute__((address_space(3)))
typedef unsigned short bf16;
typedef unsigned v4u __attribute__((ext_vector_type(4)));
typedef float f32x4 __attribute__((ext_vector_type(4)));
typedef short bf16x8 __attribute__((ext_vector_type(8)));
#define LDS_WAIT() asm volatile("s_waitcnt lgkmcnt(0)" ::: "memory")
#define DI __device__ __forceinline__

DI unsigned f2bf(float f) { unsigned u = __builtin_bit_cast(unsigned, f); return (u + 0x7fffu + ((u >> 16) & 1u)) >> 16; }
DI unsigned pk2(float lo, float hi) { return f2bf(lo) | (f2bf(hi) << 16); }
DI float bf2f(unsigned short h) { return __uint_as_float(((unsigned)h) << 16); }
DI float wave_sum(float v) {
#pragma unroll
    for (int o = 1; o < 64; o <<= 1) v += __shfl_xor(v, o);
    return v;
}
DI float wave_max(float v) {
#pragma unroll
    for (int o = 1; o < 64; o <<= 1) v = fmaxf(v, __shfl_xor(v, o));
    return v;
}
DI float sigmoid_f(float x) { return __builtin_amdgcn_rcpf(1.0f + __expf(-x)); }
DI float silu2_f(float x) { return x * sigmoid_f(x); }
DI void rope_cs(float pos, int i, float& c, float& s) {
    const float inv = __builtin_amdgcn_exp2f(-(float)i * 2.3664460711655217f);
    float rev = (pos * inv) * 0.15915494309189535f;
    rev = rev - floorf(rev);
    s = __builtin_amdgcn_sinf(rev); c = __builtin_amdgcn_cosf(rev);
}
DI void unpack8(const v4u raw, float (&f)[8]) {
#pragma unroll
    for (int i = 0; i < 4; ++i) { f[2 * i] = __uint_as_float(raw[i] << 16); f[2 * i + 1] = __uint_as_float(raw[i] & 0xffff0000u); }
}
DI v4u pack8(const float (&f)[8]) { v4u o; o.x = pk2(f[0], f[1]); o.y = pk2(f[2], f[3]); o.z = pk2(f[4], f[5]); o.w = pk2(f[6], f[7]); return o; }
DI float rope_elem(const bf16* hp, int d, float pos) {
    const int i = d & 7; float c, s; rope_cs(pos, i, c, s);
    const float x1 = bf2f(hp[i]), x2 = bf2f(hp[i + 8]);
    return d < 8 ? x1 * c - x2 * s : x2 * c + x1 * s;
}

template <int MODE> DI void tr_item(const float* W, int K, int N, const float* gain, bf16* WT, LAS float* scr, int item, int lane) {
    const int nblk = N / 32, kb = item / nblk, nb = item % nblk, k0 = 64 * kb, n0 = 32 * nb;
#pragma unroll
    for (int i = 0; i < 32; ++i) { const int kk = 2 * i + (lane >> 5); float w = W[(size_t)(k0 + kk) * N + n0 + (lane & 31)]; if (gain) w *= gain[k0 + kk]; scr[kk * 33 + (lane & 31)] = w; }
    LDS_WAIT(); asm volatile("" ::: "memory");
    const int c = lane & 7;
#pragma unroll
    for (int j = 0; j < 4; ++j) { const int n = (lane >> 3) + 8 * j; const LAS float* s = scr + (8 * c) * 33 + n;
        v4u o; o.x = pk2(s[0 * 33], s[1 * 33]); o.y = pk2(s[2 * 33], s[3 * 33]); o.z = pk2(s[4 * 33], s[5 * 33]); o.w = pk2(s[6 * 33], s[7 * 33]);
        const int ns = n0 + n; int drow = ns;
        if (MODE == 1) drow = ns < DFF ? ((ns >> 7) * 256 + (ns & 127)) : (((ns - DFF) >> 7) * 256 + 128 + ((ns - DFF) & 127));
        *(v4u*)(WT + (size_t)drow * K + k0 + 8 * c) = o; }
    LDS_WAIT(); asm volatile("" ::: "memory");
}
template <int MODE> DI void tr_item64(const float* W, int K, int N, const float* gain, bf16* WT, LAS float* scr, int item, int lane) {
    const int nblk = N / 64, kb = item / nblk, nb = item % nblk, k0 = 64 * kb, n0 = 64 * nb;
    const int kr = lane >> 4, nc = lane & 15;
    f32x4 v[16];
#pragma unroll
    for (int it = 0; it < 16; ++it) v[it] = *(const f32x4*)(W + (size_t)(k0 + 4 * it + kr) * N + n0 + 4 * nc);
#pragma unroll
    for (int it = 0; it < 16; ++it) { const int k = 4 * it + kr; const float gk = gain ? gain[k0 + k] : 1.0f;
        scr[(4 * nc + 0) * 65 + k] = v[it].x * gk; scr[(4 * nc + 1) * 65 + k] = v[it].y * gk; scr[(4 * nc + 2) * 65 + k] = v[it].z * gk; scr[(4 * nc + 3) * 65 + k] = v[it].w * gk; }
    LDS_WAIT(); asm volatile("" ::: "memory");
    const int c = lane & 7;
#pragma unroll
    for (int j = 0; j < 8; ++j) { const int n = (lane >> 3) + 8 * j; const LAS float* sp = scr + n * 65 + 8 * c;
        v4u o; o.x = pk2(sp[0], sp[1]); o.y = pk2(sp[2], sp[3]); o.z = pk2(sp[4], sp[5]); o.w = pk2(sp[6], sp[7]);
        const int ns = n0 + n; int drow = ns;
        if (MODE == 1) drow = ns < DFF ? ((ns >> 7) * 256 + (ns & 127)) : (((ns - DFF) >> 7) * 256 + 128 + ((ns - DFF) & 127));
        *(v4u*)(WT + (size_t)drow * K + k0 + 8 * c) = o; }
    LDS_WAIT(); asm volatile("" ::: "memory");
}
DI void norm_row_to_bf16(const float* xrow, bf16* orow, int lane) {
    const f32x4* xr = (const f32x4*)xrow + lane;
    f32x4 v[4]; float s = 0.f;
#pragma unroll
    for (int j = 0; j < 4; ++j) { v[j] = xr[64 * j]; s += (v[j].x * v[j].x + v[j].y * v[j].y) + (v[j].z * v[j].z + v[j].w * v[j].w); }
    const float r = __builtin_amdgcn_rsqf(wave_sum(s) * (1.f / DM) + EPS);
    unsigned long long* o8 = (unsigned long long*)orow + lane;
#pragma unroll
    for (int j = 0; j < 4; ++j) o8[64 * j] = (unsigned long long)pk2(v[j].x * r, v[j].y * r) | ((unsigned long long)pk2(v[j].z * r, v[j].w * r) << 32);
}
DI void resid_row(const float* xrow, const float* yrow, const float* g, float coef, float* orow, bf16* xnrow, int lane, bool zero_y) {
    const f32x4* xr = (const f32x4*)xrow + lane; const f32x4* yr = (const f32x4*)yrow + lane; const f32x4* gr = (const f32x4*)g + lane;
    f32x4 xv[4], yv[4]; float s = 0.f;
#pragma unroll
    for (int j = 0; j < 4; ++j) { xv[j] = xr[64 * j]; yv[j] = yr[64 * j]; s += (yv[j].x * yv[j].x + yv[j].y * yv[j].y) + (yv[j].z * yv[j].z + yv[j].w * yv[j].w); }
    if (zero_y) {
#pragma unroll
        for (int j = 0; j < 4; ++j) ((f32x4*)yrow + lane)[64 * j] = (f32x4){0.f, 0.f, 0.f, 0.f}; }
    const float ry = __builtin_amdgcn_rsqf(wave_sum(s) * (1.f / DM) + EPS) * coef;
    float s2 = 0.f;
#pragma unroll
    for (int j = 0; j < 4; ++j) { const f32x4 gv = gr[64 * j]; xv[j] = xv[j] + (yv[j] * ry) * gv; s2 += (xv[j].x * xv[j].x + xv[j].y * xv[j].y) + (xv[j].z * xv[j].z + xv[j].w * xv[j].w); }
    f32x4* orp = (f32x4*)orow + lane;
#pragma unroll
    for (int j = 0; j < 4; ++j) orp[64 * j] = xv[j];
    if (xnrow) {
        const float r = __builtin_amdgcn_rsqf(wave_sum(s2) * (1.f / DM) + EPS);
        unsigned long long* o8 = (unsigned long long*)xnrow + lane;
#pragma unroll
        for (int j = 0; j < 4; ++j) o8[64 * j] = (unsigned long long)pk2(xv[j].x * r, xv[j].y * r) | ((unsigned long long)pk2(xv[j].z * r, xv[j].w * r) << 32);
    }
}

DI f32x4 ld4_bf16(const bf16* row, int idx) { const uint2 raw = ((const uint2*)row)[idx]; return (f32x4){__uint_as_float(raw.x << 16), __uint_as_float(raw.x & 0xffff0000u), __uint_as_float(raw.y << 16), __uint_as_float(raw.y & 0xffff0000u)}; }
template <bool XBF, bool OUTF32> DI void resid_row2(const void* xrow, const bf16* ybf, float* ysamp, const float* g, float coef, void* orow, float* rs, int lane) {
    f32x4 xv[4], yv[4]; float s = 0.f;
#pragma unroll
    for (int j = 0; j < 4; ++j) {
        xv[j] = XBF ? ld4_bf16((const bf16*)xrow, lane + 64 * j) : ((const f32x4*)xrow)[lane + 64 * j];
        yv[j] = ysamp ? ((const f32x4*)ysamp)[lane + 64 * j] : ld4_bf16(ybf, lane + 64 * j);
        s += (yv[j].x * yv[j].x + yv[j].y * yv[j].y) + (yv[j].z * yv[j].z + yv[j].w * yv[j].w); }
    if (ysamp) {
#pragma unroll
        for (int j = 0; j < 4; ++j) ((f32x4*)ysamp)[lane + 64 * j] = (f32x4){0.f, 0.f, 0.f, 0.f}; }
    const float ry = __builtin_amdgcn_rsqf(wave_sum(s) * (1.f / DM) + EPS) * coef;
    float s2 = 0.f;
#pragma unroll
    for (int j = 0; j < 4; ++j) { const f32x4 gv = ((const f32x4*)g)[lane + 64 * j]; xv[j] = xv[j] + (yv[j] * ry) * gv; s2 += (xv[j].x * xv[j].x + xv[j].y * xv[j].y) + (xv[j].z * xv[j].z + xv[j].w * xv[j].w); }
    if (OUTF32) {
#pragma unroll
        for (int j = 0; j < 4; ++j) ((f32x4*)orow)[lane + 64 * j] = xv[j];
    } else {
        const float r = __builtin_amdgcn_rsqf(wave_sum(s2) * (1.f / DM) + EPS);
#pragma unroll
        for (int j = 0; j < 4; ++j) { uint2 w; w.x = pk2(xv[j].x, xv[j].y); w.y = pk2(xv[j].z, xv[j].w); ((uint2*)orow)[lane + 64 * j] = w; }
        if (lane == 0) *rs = r;
    }
}
DI void cvt_row_to_bf16(const float* xrow, bf16* orow, float* rs, int lane) {
    f32x4 v[4]; float s = 0.f;
#pragma unroll
    for (int j = 0; j < 4; ++j) { v[j] = ((const f32x4*)xrow)[lane + 64 * j]; s += (v[j].x * v[j].x + v[j].y * v[j].y) + (v[j].z * v[j].z + v[j].w * v[j].w); }
    const float r = __builtin_amdgcn_rsqf(wave_sum(s) * (1.f / DM) + EPS);
#pragma unroll
    for (int j = 0; j < 4; ++j) { uint2 w; w.x = pk2(v[j].x, v[j].y); w.y = pk2(v[j].z, v[j].w); ((uint2*)orow)[lane + 64 * j] = w; }
    if (lane == 0) *rs = r;
}

template <bool XBF, bool OUTF32, int R> DI void resid_rows(const float* xp, const float* xs, const bf16* XAin, const bf16* Yb, const float* YS, int nchunk, const float* g, float coef, float* outf, bf16* XAout, float* RS, int m0, int mstride, int lane) {
    f32x4 xv[R][4], yv[R][4];
#pragma unroll
    for (int i = 0; i < R; ++i) { const int m = m0 + i * mstride;
        if (m < MTOK) {
            const float* xf = m < MPROMPT ? xp + (size_t)m * DM : xs + (size_t)(m - MPROMPT) * DM;
#pragma unroll
            for (int j = 0; j < 4; ++j) {
                xv[i][j] = XBF ? ld4_bf16(XAin + (size_t)m * DM, lane + 64 * j) : ((const f32x4*)xf)[lane + 64 * j];
                if (m >= MPROMPT) { f32x4 a = (f32x4){0.f, 0.f, 0.f, 0.f};
                    for (int c = 0; c < nchunk; ++c) a += ((const f32x4*)(YS + ((size_t)c * 128 + (m - MPROMPT)) * DM))[lane + 64 * j];
                    yv[i][j] = a; }
                else yv[i][j] = ld4_bf16(Yb + (size_t)m * DM, lane + 64 * j); }
        } }
#pragma unroll
    for (int i = 0; i < R; ++i) { const int m = m0 + i * mstride;
        if (m < MTOK) {
            float s = 0.f;
#pragma unroll
            for (int j = 0; j < 4; ++j) s += (yv[i][j].x * yv[i][j].x + yv[i][j].y * yv[i][j].y) + (yv[i][j].z * yv[i][j].z + yv[i][j].w * yv[i][j].w);
            const float ry = __builtin_amdgcn_rsqf(wave_sum(s) * (1.f / DM) + EPS) * coef;
            float s2 = 0.f;
#pragma unroll
            for (int j = 0; j < 4; ++j) { const f32x4 gv = ((const f32x4*)g)[lane + 64 * j]; const f32x4 o = xv[i][j] + (yv[i][j] * ry) * gv; xv[i][j] = o; s2 += (o.x * o.x + o.y * o.y) + (o.z * o.z + o.w * o.w); }
            if (OUTF32) {
#pragma unroll
                for (int j = 0; j < 4; ++j) ((f32x4*)(outf + (size_t)m * DM))[lane + 64 * j] = xv[i][j];
            } else {
                const float r = __builtin_amdgcn_rsqf(wave_sum(s2) * (1.f / DM) + EPS);
#pragma unroll
                for (int j = 0; j < 4; ++j) { uint2 w; w.x = pk2(xv[i][j].x, xv[i][j].y); w.y = pk2(xv[i][j].z, xv[i][j].w); ((uint2*)(XAout + (size_t)m * DM))[lane + 64 * j] = w; }
                if (lane == 0) RS[m] = r;
            }
        } }
}
template <int R> DI void cvt_rows(const float* xp, const float* xs, bf16* XA, float* RS, int m0, int mstride, int lane) {
    f32x4 v[R][4];
#pragma unroll
    for (int i = 0; i < R; ++i) { const int m = m0 + i * mstride;
        if (m < MTOK) { const float* xf = m < MPROMPT ? xp + (size_t)m * DM : xs + (size_t)(m - MPROMPT) * DM;
#pragma unroll
            for (int j = 0; j < 4; ++j) v[i][j] = ((const f32x4*)xf)[lane + 64 * j]; } }
#pragma unroll
    for (int i = 0; i < R; ++i) { const int m = m0 + i * mstride;
        if (m < MTOK) { float s = 0.f;
#pragma unroll
            for (int j = 0; j < 4; ++j) s += (v[i][j].x * v[i][j].x + v[i][j].y * v[i][j].y) + (v[i][j].z * v[i][j].z + v[i][j].w * v[i][j].w);
            const float r = __builtin_amdgcn_rsqf(wave_sum(s) * (1.f / DM) + EPS);
#pragma unroll
            for (int j = 0; j < 4; ++j) { uint2 w; w.x = pk2(v[i][j].x, v[i][j].y); w.y = pk2(v[i][j].z, v[i][j].w); ((uint2*)(XA + (size_t)m * DM))[lane + 64 * j] = w; }
            if (lane == 0) RS[m] = r;
        } else if (m < MPAD) {
#pragma unroll
            for (int j = 0; j < 4; ++j) ((uint2*)(XA + (size_t)m * DM))[lane + 64 * j] = (uint2){0u, 0u};
            if (lane == 0) RS[m] = 0.f; } }
}

#define MFMA16(a, b, c) __builtin_amdgcn_mfma_f32_16x16x32_bf16((a), (b), (c), 0, 0, 0)

constexpr int AT_KS = 0, AT_KS_ROW = 144, AT_VT = 36864, AT_VT_ROW = 528, AT_PS = AT_VT + 64 * 528, AT_PS_WAVE = 16 * 528;
static_assert(AT_PS + 8 * AT_PS_WAVE <= LDS_BYTES, "attention LDS");
DI void attn_prompt_unit(LAS unsigned char* lds, const bf16* P, bf16* CAT, const float* sinks, int b, int nbk, int kvh, int tid, int lane, int wave) {
    {
        const int kj = tid >> 1, half = tid & 1; const int t = 128 * (nbk - 1) + kj;
        LAS unsigned char* krow = lds + AT_KS + kj * AT_KS_ROW + half * 64;
        LAS bf16* vt = (LAS bf16*)(lds + AT_VT);
        if (t < 0) {
            const v4u z = (v4u){0u, 0u, 0u, 0u};
#pragma unroll
            for (int c = 0; c < 4; ++c) *(LAS v4u*)(krow + 16 * c) = z;
#pragma unroll
            for (int i = 0; i < 32; ++i) vt[(32 * half + i) * (AT_VT_ROW / 2) + kj] = 0;
        } else {
            const bf16* prow = P + (size_t)(b * SEQ + t) * NIN;
            const v4u* kp = (const v4u*)(prow + C_K + 64 * kvh + 32 * half);
            v4u c0 = kp[0], c1 = kp[1], c2 = kp[2], c3 = kp[3];
            if (half == 0) {
                float x1[8], x2[8], o1[8], o2[8]; unpack8(c0, x1); unpack8(c1, x2);
#pragma unroll
                for (int i = 0; i < 8; ++i) { float c, s; rope_cs((float)t, i, c, s); o1[i] = x1[i] * c - x2[i] * s; o2[i] = x2[i] * c + x1[i] * s; }
                c0 = pack8(o1); c1 = pack8(o2);
            }
            *(LAS v4u*)(krow) = c0; *(LAS v4u*)(krow + 16) = c1; *(LAS v4u*)(krow + 32) = c2; *(LAS v4u*)(krow + 48) = c3;
            const v4u* vp = (const v4u*)(prow + C_V + 64 * kvh + 32 * half);
#pragma unroll
            for (int c = 0; c < 4; ++c) { const v4u raw = vp[c];
#pragma unroll
                for (int i = 0; i < 4; ++i) { vt[(32 * half + 8 * c + 2 * i) * (AT_VT_ROW / 2) + kj] = (bf16)(raw[i] & 0xffffu); vt[(32 * half + 8 * c + 2 * i + 1) * (AT_VT_ROW / 2) + kj] = (bf16)(raw[i] >> 16); } }
        }
    }
    __syncthreads();
    const int g = wave >> 1, qhalf = wave & 1, h = 4 * kvh + g, fr = lane & 15, fq = lane >> 4;
    const float sink2 = sinks[h] * LOG2E;
    LAS unsigned char* ps = lds + AT_PS + wave * AT_PS_WAVE;
#pragma unroll 1
    for (int sb = 0; sb < 4; ++sb) {
        const int q0 = 64 * qhalf + 16 * sb;
        bf16x8 qa[2];
        {
            const int qi = q0 + fr; const int t = 128 * nbk + qi;
            const bf16* qp = P + (size_t)(b * SEQ + t) * NIN + C_Q + 64 * h;
            v4u r0 = *(const v4u*)(qp + 8 * fq), r1 = *(const v4u*)(qp + 32 + 8 * fq);
            if (fq < 2) {
                const v4u other = *(const v4u*)(qp + 8 * (fq ^ 1));
                float a[8], o[8], x[8]; unpack8(r0, a); unpack8(other, o);
#pragma unroll
                for (int i = 0; i < 8; ++i) { float c, s; rope_cs((float)t, i, c, s); x[i] = fq == 0 ? a[i] * c - o[i] * s : a[i] * c + o[i] * s; }
                r0 = pack8(x);
            }
            qa[0] = __builtin_bit_cast(bf16x8, r0); qa[1] = __builtin_bit_cast(bf16x8, r1);
        }
        f32x4 sc[16];
#pragma unroll
        for (int n = 0; n < 16; ++n) {
            sc[n] = (f32x4){0.f, 0.f, 0.f, 0.f};
#pragma unroll
            for (int ks = 0; ks < 2; ++ks) { const bf16x8 kb = *(const LAS bf16x8*)(lds + AT_KS + (16 * n + fr) * AT_KS_ROW + (32 * ks + 8 * fq) * 2); sc[n] = MFMA16(qa[ks], kb, sc[n]); }
        }
        float mx[4], sm[4];
#pragma unroll
        for (int j = 0; j < 4; ++j) {
            const int qi = q0 + 4 * fq + j; float m = -1e30f;
#pragma unroll
            for (int n = 0; n < 16; ++n) { const int kj = 16 * n + fr; const bool valid = (kj > qi) && (kj <= qi + 128) && (nbk > 0 || kj >= 128);
                const float v = valid ? sc[n][j] * (0.125f * LOG2E) : -1e30f; sc[n][j] = v; m = fmaxf(m, v); }
            m = fmaxf(m, __shfl_xor(m, 1)); m = fmaxf(m, __shfl_xor(m, 2)); m = fmaxf(m, __shfl_xor(m, 4)); m = fmaxf(m, __shfl_xor(m, 8));
            m = fmaxf(m, sink2); mx[j] = m;
            float s = 0.f;
#pragma unroll
            for (int n = 0; n < 16; ++n) { const float p = __builtin_amdgcn_exp2f(sc[n][j] - m); sc[n][j] = p; s += p; }
            s += __shfl_xor(s, 1); s += __shfl_xor(s, 2); s += __shfl_xor(s, 4); s += __shfl_xor(s, 8);
            sm[j] = __builtin_amdgcn_rcpf(s + __builtin_amdgcn_exp2f(sink2 - m));
        }
#pragma unroll
        for (int n = 0; n < 16; ++n)
#pragma unroll
            for (int j = 0; j < 4; ++j) *(LAS bf16*)(ps + (4 * fq + j) * AT_VT_ROW + (16 * n + fr) * 2) = (bf16)f2bf(sc[n][j]);
        LDS_WAIT(); asm volatile("" ::: "memory");
        f32x4 o[4];
#pragma unroll
        for (int n = 0; n < 4; ++n) o[n] = (f32x4){0.f, 0.f, 0.f, 0.f};
#pragma unroll
        for (int ks = 0; ks < 8; ++ks) { const bf16x8 pa = *(const LAS bf16x8*)(ps + fr * AT_VT_ROW + (32 * ks + 8 * fq) * 2);
#pragma unroll
            for (int n = 0; n < 4; ++n) { const bf16x8 vb = *(const LAS bf16x8*)(lds + AT_VT + (16 * n + fr) * AT_VT_ROW + (32 * ks + 8 * fq) * 2); o[n] = MFMA16(pa, vb, o[n]); } }
        LDS_WAIT(); asm volatile("" ::: "memory");
#pragma unroll
        for (int j = 0; j < 4; ++j) { bf16* op = CAT + (size_t)(b * SEQ + 128 * nbk + q0 + 4 * fq + j) * DM + 64 * h + fr;
#pragma unroll
            for (int n = 0; n < 4; ++n) op[16 * n] = (bf16)f2bf(o[n][j] * sm[j]); }
    }
    __syncthreads();
}

constexpr int HG_ROW = 144, HG_WAVE_LDS = 18432;
DI void hgrn_gate_unit(LAS unsigned char* ldsw, const bf16* P, const float* lbv, bf16* QE, bf16* KE, bf16* VTg, bf16* UT, float* Dws, int b, int h, int c, int lane) {
    const int r0 = b * SEQ + 64 * c, unit = (b * 8 + h) * 64 + c, fr = lane & 15, fq = lane >> 4;
    const float lb = lbv[64 * h + lane];
    const bf16* pp = P + (size_t)r0 * NIN + 64 * h + lane;
    bf16* qep = QE + (size_t)r0 * 512 + 64 * h + lane; bf16* kep = KE + (size_t)r0 * 512 + 64 * h + lane;
    {
        unsigned w[64];
#pragma unroll
        for (int t = 0; t < 64; ++t) w[t] = pp[(size_t)t * NIN + C_HI];
#pragma unroll
        for (int s8 = 0; s8 < 8; ++s8) {
            const v4u o = (v4u){w[8 * s8] | (w[8 * s8 + 1] << 16), w[8 * s8 + 2] | (w[8 * s8 + 3] << 16), w[8 * s8 + 4] | (w[8 * s8 + 5] << 16), w[8 * s8 + 6] | (w[8 * s8 + 7] << 16)};
            *(LAS v4u*)(ldsw + 9216 + lane * HG_ROW + 16 * s8) = o;
            *(v4u*)(VTg + (size_t)unit * 4096 + lane * 64 + 8 * s8) = o; }
    }
    float ke[64]; float run = 0.f;
    {
        unsigned short hfr[64], hqr[64];
#pragma unroll
        for (int t = 0; t < 64; ++t) { hfr[t] = pp[(size_t)t * NIN + C_HF]; hqr[t] = pp[(size_t)t * NIN + C_HQ]; }
#pragma unroll
        for (int t = 0; t < 64; ++t) {
            const float hf = bf2f(hfr[t]), hq = bf2f(hqr[t]);
            const float f = lb + (1.0f - lb) * sigmoid_f(hf); run += __logf(f);
            qep[t * 512] = (bf16)f2bf(hq * 0.125f * __expf(run));
            const float k_ = (1.0f - f) * __expf(-run); kep[t * 512] = (bf16)f2bf(k_); ke[t] = k_;
        }
    }
    const float D = __expf(run);
    Dws[(size_t)unit * 64 + lane] = D;
#pragma unroll
    for (int s8 = 0; s8 < 8; ++s8) { float kd[8];
#pragma unroll
        for (int i = 0; i < 8; ++i) kd[i] = ke[8 * s8 + i] * D;
        *(LAS v4u*)(ldsw + lane * HG_ROW + 16 * s8) = pack8(kd); }
    LDS_WAIT(); asm volatile("" ::: "memory");
    bf16x8 vb[4][2];
#pragma unroll
    for (int nb = 0; nb < 4; ++nb)
#pragma unroll
        for (int ks = 0; ks < 2; ++ks) vb[nb][ks] = *(const LAS bf16x8*)(ldsw + 9216 + (16 * nb + fr) * HG_ROW + (32 * ks + 8 * fq) * 2);
#pragma unroll
    for (int mb = 0; mb < 4; ++mb) {
        bf16x8 ka[2];
#pragma unroll
        for (int ks = 0; ks < 2; ++ks) ka[ks] = *(const LAS bf16x8*)(ldsw + (16 * mb + fr) * HG_ROW + (32 * ks + 8 * fq) * 2);
#pragma unroll
        for (int nb = 0; nb < 4; ++nb) { f32x4 acc = (f32x4){0.f, 0.f, 0.f, 0.f};
            acc = MFMA16(ka[0], vb[nb][0], acc); acc = MFMA16(ka[1], vb[nb][1], acc);
            uint2 o; o.x = pk2(acc[0], acc[1]); o.y = pk2(acc[2], acc[3]);
            *(uint2*)(UT + (size_t)unit * 4096 + (16 * nb + fr) * 64 + 16 * mb + 4 * fq) = o; }
    }
    LDS_WAIT(); asm volatile("" ::: "memory");
}
DI void hgrn_out_unit(const bf16* P, const bf16* QE, const bf16* KE, const bf16* VTg, const bf16* SPT, const float* outg, bf16* CAT, int b, int h, int c, int lane) {
    const int r0 = b * SEQ + 64 * c, unit = (b * 8 + h) * 64 + c, fr = lane & 15, fq = lane >> 4;
    const bf16* qep = QE + (size_t)r0 * 512 + 64 * h; const bf16* kep = KE + (size_t)r0 * 512 + 64 * h;
    const bf16* vtp = VTg + (size_t)unit * 4096; const bf16* spp = SPT + (size_t)unit * 4096;
    bf16x8 spa[4][2], vta[4][2];
#pragma unroll
    for (int mb = 0; mb < 4; ++mb)
#pragma unroll
        for (int ks = 0; ks < 2; ++ks) {
            spa[mb][ks] = *(const bf16x8*)(spp + (16 * mb + fr) * 64 + 32 * ks + 8 * fq);
            const uint2 lo = *(const uint2*)(vtp + (16 * mb + fr) * 64 + 32 * ks + 4 * fq), hi = *(const uint2*)(vtp + (16 * mb + fr) * 64 + 32 * ks + 16 + 4 * fq);
            vta[mb][ks] = __builtin_bit_cast(bf16x8, ((v4u){lo.x, lo.y, hi.x, hi.y}));
        }
    f32x4 og[4];
#pragma unroll
    for (int mb = 0; mb < 4; ++mb) og[mb] = *(const f32x4*)(outg + 16 * mb + 4 * fq);
    bf16x8 qbs[4][2], kas[4][2];
#pragma unroll
    for (int nb = 0; nb < 4; ++nb)
#pragma unroll
        for (int ks = 0; ks < 2; ++ks) { qbs[nb][ks] = *(const bf16x8*)(qep + (size_t)(16 * nb + fr) * 512 + 32 * ks + 8 * fq); kas[nb][ks] = *(const bf16x8*)(kep + (size_t)(16 * nb + fr) * 512 + 32 * ks + 8 * fq); }
#pragma unroll
    for (int nb = 0; nb < 4; ++nb) {
        uint2 hgs[4];
#pragma unroll
        for (int mb = 0; mb < 4; ++mb) hgs[mb] = *(const uint2*)(P + (size_t)(r0 + 16 * nb + fr) * NIN + C_HG + 64 * h + 16 * mb + 4 * fq);
        f32x4 at[4];
#pragma unroll
        for (int sb = 0; sb < 4; ++sb) { at[sb] = (f32x4){0.f, 0.f, 0.f, 0.f};
            if (sb <= nb) {
                at[sb] = MFMA16(kas[sb][0], qbs[nb][0], at[sb]); at[sb] = MFMA16(kas[sb][1], qbs[nb][1], at[sb]);
                if (sb == nb) {
#pragma unroll
                    for (int j = 0; j < 4; ++j) if (4 * fq + j > fr) at[sb][j] = 0.f;
                }
            } }
        bf16x8 bat[2];
#pragma unroll
        for (int p = 0; p < 2; ++p) bat[p] = __builtin_bit_cast(bf16x8, ((v4u){pk2(at[2 * p][0], at[2 * p][1]), pk2(at[2 * p][2], at[2 * p][3]), pk2(at[2 * p + 1][0], at[2 * p + 1][1]), pk2(at[2 * p + 1][2], at[2 * p + 1][3])}));
        f32x4 o[4]; float ss = 0.f;
#pragma unroll
        for (int mb = 0; mb < 4; ++mb) { o[mb] = (f32x4){0.f, 0.f, 0.f, 0.f};
            o[mb] = MFMA16(spa[mb][0], qbs[nb][0], o[mb]); o[mb] = MFMA16(spa[mb][1], qbs[nb][1], o[mb]);
            o[mb] = MFMA16(vta[mb][0], bat[0], o[mb]); if (nb >= 2) o[mb] = MFMA16(vta[mb][1], bat[1], o[mb]);
            ss += (o[mb][0] * o[mb][0] + o[mb][1] * o[mb][1]) + (o[mb][2] * o[mb][2] + o[mb][3] * o[mb][3]); }
        ss += __shfl_xor(ss, 16); ss += __shfl_xor(ss, 32);
        const float r = __builtin_amdgcn_rsqf(ss * (1.0f / 64.0f) + EPS);
        const size_t row = (size_t)(r0 + 16 * nb + fr);
#pragma unroll
        for (int mb = 0; mb < 4; ++mb) {
            const uint2 hgr = hgs[mb];
            const float g0 = __uint_as_float(hgr.x << 16), g1 = __uint_as_float(hgr.x & 0xffff0000u), g2 = __uint_as_float(hgr.y << 16), g3 = __uint_as_float(hgr.y & 0xffff0000u);
            uint2 w; w.x = pk2(o[mb][0] * r * og[mb][0] * silu2_f(g0), o[mb][1] * r * og[mb][1] * silu2_f(g1)); w.y = pk2(o[mb][2] * r * og[mb][2] * silu2_f(g2), o[mb][3] * r * og[mb][3] * silu2_f(g3));
            *(uint2*)(CAT + row * DM + 512 + 64 * h + 16 * mb + 4 * fq) = w; }
    }
}

constexpr int SA_KL = 0, SA_VL = 33280, SA_QL = 66048, SA_SL = 67072, SA_RL = 69120;
DI void attn_sample_unit(LAS unsigned char* lds, const bf16* P, const float* cache_k, const float* cache_v, const float* sinks, float* out, bf16* CAT, int b, int kvh, int tid, int lane, int wave) {
    LAS float* KL = (LAS float*)(lds + SA_KL); LAS float* VL = (LAS float*)(lds + SA_VL); LAS float* QL = (LAS float*)(lds + SA_QL); LAS float* SL = (LAS float*)(lds + SA_SL); LAS float* RL = (LAS float*)(lds + SA_RL);
    const bf16* prow = P + (size_t)(MPROMPT + b) * NIN;
#pragma unroll 4
    for (int i = 0; i < 16; ++i) { const int idx = tid + 512 * i, key = idx >> 6, d = idx & 63; float kv, vv;
        if (key < 127) { const size_t src = ((size_t)(b * 128 + key + 1) * 2 + kvh) * 64 + d; kv = cache_k[src]; vv = cache_v[src]; }
        else { const bf16* hp = prow + C_K + 64 * kvh; kv = d < 16 ? rope_elem(hp, d, PAST_POS) : bf2f(hp[d]); vv = bf2f(prow[C_V + 64 * kvh + d]); }
        KL[key * 65 + d] = kv; VL[key * 64 + d] = vv;
        const size_t dst = ((size_t)(b * 128 + key) * 2 + kvh) * 64 + d; out[O_WKS + dst] = kv; out[O_WVS + dst] = vv; }
    if (tid < 256) { const int g = tid >> 6, d = tid & 63; const bf16* hp = prow + C_Q + 64 * (4 * kvh + g);
        const float q = d < 16 ? rope_elem(hp, d, PAST_POS) : bf2f(hp[d]); QL[g * 64 + d] = q * (0.125f * LOG2E); }
    __syncthreads();
    { const int g = tid >> 7, j = tid & 127; float s = 0.f;
#pragma unroll 16
      for (int d = 0; d < 64; ++d) s += QL[g * 64 + d] * KL[j * 65 + d];
      SL[g * 128 + j] = s; }
    __syncthreads();
    if (wave < 4) { const int g = wave; const float sink2 = sinks[4 * kvh + g] * LOG2E; const float s0 = SL[g * 128 + lane], s1 = SL[g * 128 + 64 + lane];
        const float m = fmaxf(wave_max(fmaxf(s0, s1)), sink2); const float p0 = __builtin_amdgcn_exp2f(s0 - m), p1 = __builtin_amdgcn_exp2f(s1 - m);
        const float sum = wave_sum(p0 + p1) + __builtin_amdgcn_exp2f(sink2 - m); SL[g * 128 + lane] = p0; SL[g * 128 + 64 + lane] = p1; if (lane == 0) RL[g] = 1.0f / sum; }
    __syncthreads();
    if (tid < 256) { const int g = tid >> 6, d = tid & 63; float o = 0.f;
#pragma unroll 16
        for (int j = 0; j < 128; ++j) o += SL[g * 128 + j] * VL[j * 64 + d];
        CAT[(size_t)(MPROMPT + b) * DM + 64 * (4 * kvh + g) + d] = (bf16)f2bf(o * RL[g]); }
    __syncthreads();
}
DI void hgrn_sample_unit(const bf16* P, const float* lbv, const float* state, const float* outg, float* out, bf16* CAT, int b, int h, int lane) {
    const bf16* prow = P + (size_t)(MPROMPT + b) * NIN + 64 * h + lane;
    const float lb = lbv[64 * h + lane];
    const float q = bf2f(prow[C_HQ]) * 0.125f, f = lb + (1.0f - lb) * sigmoid_f(bf2f(prow[C_HF])), kk = 1.0f - f, v = bf2f(prow[C_HI]), hg = bf2f(prow[C_HG]);
    const float* S = state + (size_t)(b * 8 + h) * 4096 + lane; float* So = out + O_SS + (size_t)(b * 8 + h) * 4096 + lane;
    float o = 0.f; float sv[64];
#pragma unroll
    for (int k = 0; k < 64; ++k) sv[k] = S[k * 64];
#pragma unroll
    for (int k = 0; k < 64; ++k) { const float fk = __shfl(f, k), kkk = __shfl(kk, k), qk = __shfl(q, k); const float sn = fk * sv[k] + kkk * v; So[k * 64] = sn; o += qk * sn; }
    const float r = __builtin_amdgcn_rsqf(wave_sum(o * o) * (1.0f / 64.0f) + EPS);
    CAT[(size_t)(MPROMPT + b) * DM + 512 + 64 * h + lane] = (bf16)f2bf(o * r * outg[lane] * silu2_f(hg));
}

#define XB_TMO      128
#define XB_XCNT(j)  (256  + 64 * (j))
#define XB_XSUB(j)  (1280 + 64 * (j))
#define XB_XGEN(j)  (2304 + 64 * (j))
#define XB_TOP      3328
#define XB_TOPGEN   3392
#define XCD_BAR_WORDS 3456
#define XB_SPIN_CAP (1u << 18)

__device__ __forceinline__ unsigned xb_ld(unsigned* p)              { return __hip_atomic_load(p, __ATOMIC_RELAXED, __HIP_MEMORY_SCOPE_AGENT); }
__device__ __forceinline__ unsigned xb_add(unsigned* p, unsigned v) { return __hip_atomic_fetch_add(p, v, __ATOMIC_RELAXED, __HIP_MEMORY_SCOPE_AGENT); }
__device__ __forceinline__ unsigned xb_xcc_id() { return (unsigned)__builtin_amdgcn_s_getreg((3 << 11) | 20) & 0xFu; }
#define XB_SPIN(cond, bar) do { unsigned _sp = 0; while (cond) { __builtin_amdgcn_s_sleep(1); \
    if ((++_sp & 255u) == 0u) { if (xb_ld(&(bar)[XB_TMO])) break; if (_sp > XB_SPIN_CAP) { atomicAdd(&(bar)[XB_TMO], 1u); break; } } } } while (0)

struct XcdBarrier {
    unsigned* bar; unsigned x;
    volatile LAS unsigned* st;
};

__device__ __forceinline__ XcdBarrier xcd_barrier_post(unsigned* bar, volatile LAS unsigned* st) {
    XcdBarrier b; b.bar = bar; b.x = xb_xcc_id(); b.st = st;
    if (threadIdx.x == 0) (void)xb_add(&bar[XB_XCNT(b.x)], 1u);
    return b;
}
__device__ __forceinline__ void xcd_barrier_complete(unsigned* bar, unsigned x, unsigned& nloc, unsigned& nx) {
    const unsigned G = gridDim.x * gridDim.y * gridDim.z;
    unsigned sum, cnt, mine, sp = 0u;
    for (;;) {
        sum = 0u; cnt = 0u; mine = 0u;
#pragma unroll
        for (unsigned j = 0; j < 16; ++j) { const unsigned c = xb_ld(&bar[XB_XCNT(j)]); sum += c; cnt += (c > 0u) ? 1u : 0u; mine = (j == x) ? c : mine; }
        if (sum == G) break;
        __builtin_amdgcn_s_sleep(1);
        if ((++sp & 255u) == 0u) { if (xb_ld(&bar[XB_TMO])) break; if (sp > XB_SPIN_CAP) { atomicAdd(&bar[XB_TMO], 1u); break; } }
    }
    nloc = mine > 0u ? mine : 1u; nx = cnt > 0u ? cnt : 1u;
}

__device__ __forceinline__ void xcd_barrier(const XcdBarrier& b) {
    asm volatile("s_waitcnt vmcnt(0)" ::: "memory");
    __syncthreads();
    if (threadIdx.x == 0) {
        unsigned* bar = b.bar;
        __builtin_amdgcn_s_waitcnt(0);
        unsigned nloc = b.st[0], nx = b.st[1];
        if (nloc == 0u) { xcd_barrier_complete(bar, b.x, nloc, nx); b.st[0] = nloc; b.st[1] = nx; }
        const unsigned old = xb_add(&bar[XB_XSUB(b.x)], 1u);
        const unsigned gen = old / nloc;
        if (old + 1u == (gen + 1u) * nloc) {
            __builtin_amdgcn_fence(__ATOMIC_RELEASE, "agent");
            asm volatile("s_waitcnt vmcnt(0)" ::: "memory");
            const unsigned og = xb_add(&bar[XB_TOP], 1u);
            const unsigned tg = og / nx;
            if (og + 1u == (tg + 1u) * nx) xb_add(&bar[XB_TOPGEN], 1u);
            else XB_SPIN(xb_ld(&bar[XB_TOPGEN]) == tg, bar);
            __builtin_amdgcn_fence(__ATOMIC_ACQUIRE, "agent");
            xb_add(&bar[XB_XGEN(b.x)], 1u);
            asm volatile("s_waitcnt vmcnt(0)" ::: "memory");
        } else {
            XB_SPIN(xb_ld(&bar[XB_XGEN(b.x)]) == gen, bar);
            __builtin_amdgcn_fence(__ATOMIC_ACQUIRE, "agent");
            asm volatile("s_waitcnt vmcnt(0)" ::: "memory");
        }
    }
    __syncthreads();
}

struct Args { const float* in[20]; float* out; unsigned char* ws; };
__global__ void __launch_bounds__(512, 2) mk_fwd(Args args) {
    extern __shared__ __attribute__((aligned(16))) unsigned char lds_raw[];
    cg::grid_group grid = cg::this_grid();
    LAS unsigned char* lds = (LAS unsigned char*)lds_raw;
    const int tid = threadIdx.x, lane = tid & 63, wave = __builtin_amdgcn_readfirstlane(tid >> 6);
    const int G = gridDim.x, bid = blockIdx.x, gw = bid * 8 + wave, NGW = G * 8;
    unsigned char* ws = args.ws; float* out = args.out;
    const float* x_prompt = args.in[0]; const float* x_sample = args.in[1];
    bf16* Wgu1 = (bf16*)(ws + WS_WGU1); bf16* Wdn1 = (bf16*)(ws + WS_WDN1); bf16* Win = (bf16*)(ws + WS_WIN); bf16* Wout = (bf16*)(ws + WS_WOUT);
    bf16* Wgu2 = (bf16*)(ws + WS_WGU2); bf16* Wdn2 = (bf16*)(ws + WS_WDN2);
    float* LBV = (float*)(ws + WS_LB); bf16* XA = (bf16*)(ws + WS_XA); bf16* ACT = (bf16*)(ws + WS_ACT); bf16* Y = (bf16*)(ws + WS_Y); bf16* CATB = (bf16*)(ws + WS_CAT);
    float* YS = (float*)(ws + WS_YSP); float* RS = (float*)(ws + WS_RS);
    bf16* QE = (bf16*)(ws + WS_QE); bf16* KE = (bf16*)(ws + WS_KE); bf16* VTg = (bf16*)(ws + WS_VT); bf16* UT = (bf16*)(ws + WS_UT); float* Dws = (float*)(ws + WS_D);
    if (tid < 4) ((volatile LAS unsigned*)(lds + LDS_BARW))[tid] = 0u;
    __syncthreads();
    const XcdBarrier xbar = xcd_barrier_post((unsigned*)ws, (volatile LAS unsigned*)(lds + LDS_BARW));
    if (ws == nullptr) grid.sync();
    for (int rep = 0; rep < REP_P0; ++rep) {
        LAS float* scr = (LAS float*)(lds + wave * 16640);
        constexpr int I_GU = 16 * 88, I_DN = 44 * 16, I_IN = 16 * 44, I_OUT = 16 * 16, NITEMS = 2 * I_GU + 2 * I_DN + I_IN + I_OUT, NROWG = MPAD / 4;
        for (int it = gw; it < NITEMS + NROWG; it += NGW) {
            int r = it;
            if (r < I_GU) { tr_item64<1>(args.in[7], DM, NGU, args.in[5], Wgu1, scr, r, lane); continue; } r -= I_GU;
            if (r < I_GU) { tr_item64<1>(args.in[18], DM, NGU, args.in[16], Wgu2, scr, r, lane); continue; } r -= I_GU;
            if (r < I_DN) { tr_item64<0>(args.in[8], DFF, DM, nullptr, Wdn1, scr, r, lane); continue; } r -= I_DN;
            if (r < I_DN) { tr_item64<0>(args.in[19], DFF, DM, nullptr, Wdn2, scr, r, lane); continue; } r -= I_DN;
            if (r < I_IN) { tr_item64<0>(args.in[11], DM, NIN, args.in[9], Win, scr, r, lane); continue; } r -= I_IN;
            if (r < I_OUT) { tr_item64<0>(args.in[15], DM, DM, nullptr, Wout, scr, r, lane); continue; } r -= I_OUT;
            cvt_rows<4>(x_prompt, x_sample, XA, RS, 4 * r, 1, lane);
        }
        if (bid == 0) { const float* l = args.in[13]; LBV[tid] = 1.0f / (1.0f + __expf(l[512 + tid] - l[tid])); }
    }
    xcd_barrier(xbar);
    { pg8::Gemm g{XA, Wgu1, MPAD, NGU, DM, DM}; pg8::StaticOrder S; S.init(MPAD, NGU, G, bid); pg8::EpiSwiGLU E{ACT, DFF, RS};
      pg8::gemm_phase<pg8::EpiSwiGLU, pg8::StaticOrder, true, true>(lds, g, S, E); }
    xcd_barrier(xbar);
    { pg8::Gemm g{ACT, Wdn1, MPROMPT, DM, DFF, DFF}; pg8::StaticOrder S; S.init(MPROMPT, DM, G, bid); pg8::EpiBf16 E{Y, DM, nullptr};
      pg8::gemm_phase<pg8::EpiBf16, pg8::StaticOrder, true, true>(lds, g, S, E);
      pg8::Gemm gt{ACT, Wdn1, MPAD, DM, 256, DFF}; pg8::TailOrder T{MPROMPT / 256, 4, 44, 256, (G - 1) - bid}; pg8::EpiPartF32 Et{YS, DM, 256};
      pg8::gemm_phase<pg8::EpiPartF32, pg8::TailOrder, false, true>(lds, gt, T, Et); }
    xcd_barrier(xbar);
    for (int m0 = gw; m0 < MTOK; m0 += 4 * NGW) resid_rows<false, false, 4>(x_prompt, x_sample, XA, Y, YS, 11, args.in[6], 0.5f, out, XA, RS, m0, NGW, lane);
    xcd_barrier(xbar);
    { pg8::Gemm g{XA, Win, MPAD, NIN, DM, DM}; pg8::StaticOrder S; S.init(MPAD, NIN, G, bid); pg8::EpiBf16 E{ACT, NIN, RS};
      pg8::gemm_phase<pg8::EpiBf16, pg8::StaticOrder, true, true>(lds, g, S, E); }
    xcd_barrier(xbar);
    for (int rep = 0; rep < REP_MIX; ++rep) {
    {
        const bf16* P = ACT; bf16* CAT = CATB;
        for (int u = bid; u < 256; u += G) attn_prompt_unit(lds, P, CAT, args.in[12], u >> 6, (u >> 1) & 31, u & 1, tid, lane, wave);
        for (int u = gw; u < 2048; u += NGW) hgrn_gate_unit(lds + wave * HG_WAVE_LDS, P, LBV, QE, KE, VTg, UT, Dws, u >> 9, (u >> 6) & 7, u & 63, lane);
        __syncthreads();
        for (int u = bid; u < 256; u += G) attn_sample_unit(lds, P, args.in[2], args.in[3], args.in[12], out, CAT, u >> 1, u & 1, tid, lane, wave);
        for (int u = gw; u < 1024; u += NGW) hgrn_sample_unit(P, LBV, args.in[4], args.in[14], out, CAT, u >> 3, u & 7, lane);
        for (int e = bid * 512 + tid; e < 131072; e += G * 512) {
            const int which = e >> 16, r = e & 65535, b = r >> 14, j = (r >> 7) & 127, kvh = (r >> 6) & 1, d = r & 63;
            const bf16* prow = P + (size_t)(b * SEQ + SEQ - 128 + j) * NIN;
            float v;
            if (which == 0) { const bf16* hp = prow + C_K + 64 * kvh; v = d < 16 ? rope_elem(hp, d, (float)(SEQ - 128 + j)) : bf2f(hp[d]); }
            else v = bf2f(prow[C_V + 64 * kvh + d]);
            out[O_WKP + e] = v;
        }
    }
    xcd_barrier(xbar);
    for (int e = bid * 512 + tid; e < 65536; e += G * 512) {
        const int bh = e >> 11, pr = e & 2047, k0 = (2 * pr) & 63, dv = (2 * pr) >> 6; float S0 = 0.f, S1 = 0.f;
        unsigned* up = (unsigned*)(UT + (size_t)bh * 64 * 4096) + pr; const float* dp = Dws + (size_t)bh * 64 * 64 + k0;
#pragma unroll 1
        for (int c0 = 0; c0 < 64; c0 += 32) { unsigned raw[32]; float2 dd[32];
#pragma unroll
            for (int c = 0; c < 32; ++c) { raw[c] = up[(size_t)(c0 + c) * 2048]; dd[c] = *(const float2*)(dp + (c0 + c) * 64); }
#pragma unroll
            for (int c = 0; c < 32; ++c) { up[(size_t)(c0 + c) * 2048] = pk2(S0, S1); S0 = dd[c].x * S0 + __uint_as_float(raw[c] << 16); S1 = dd[c].y * S1 + __uint_as_float(raw[c] & 0xffff0000u); } }
        out[O_SP + (size_t)bh * 4096 + k0 * 64 + dv] = S0; out[O_SP + (size_t)bh * 4096 + (k0 + 1) * 64 + dv] = S1;
    }
    xcd_barrier(xbar);
    {
        const bf16* P = ACT; bf16* CAT = CATB;
        for (int u = gw; u < 2048; u += NGW) hgrn_out_unit(P, QE, KE, VTg, UT, args.in[14], CAT, u >> 9, (u >> 6) & 7, u & 63, lane);
    }
    xcd_barrier(xbar);
    }
    { pg8::Gemm g{CATB, Wout, MPROMPT, DM, DM, DM}; pg8::StaticOrder S; S.init(MPROMPT, DM, G, bid); pg8::EpiBf16 E{Y, DM, nullptr};
      pg8::gemm_phase<pg8::EpiBf16, pg8::StaticOrder, true, true>(lds, g, S, E);
      pg8::Gemm gt{CATB, Wout, MPAD, DM, 128, DM}; pg8::TailOrder T{MPROMPT / 256, 4, 32, 128, (G - 1) - bid}; pg8::EpiPartF32 Et{YS, DM, 128};
      pg8::gemm_phase<pg8::EpiPartF32, pg8::TailOrder, false, true>(lds, gt, T, Et); }
    xcd_barrier(xbar);
    for (int m0 = gw; m0 < MTOK; m0 += 4 * NGW) resid_rows<true, false, 4>(x_prompt, x_sample, XA, Y, YS, 8, args.in[10], 1.0f, out, XA, RS, m0, NGW, lane);
    xcd_barrier(xbar);
    { pg8::Gemm g{XA, Wgu2, MPAD, NGU, DM, DM}; pg8::StaticOrder S; S.init(MPAD, NGU, G, bid); pg8::EpiSwiGLU E{ACT, DFF, RS};
      pg8::gemm_phase<pg8::EpiSwiGLU, pg8::StaticOrder, true, true>(lds, g, S, E); }
    xcd_barrier(xbar);
    { pg8::Gemm g{ACT, Wdn2, MPROMPT, DM, DFF, DFF}; pg8::StaticOrder S; S.init(MPROMPT, DM, G, bid); pg8::EpiBf16 E{Y, DM, nullptr};
      pg8::gemm_phase<pg8::EpiBf16, pg8::StaticOrder, true, true>(lds, g, S, E);
      pg8::Gemm gt{ACT, Wdn2, MPAD, DM, 256, DFF}; pg8::TailOrder T{MPROMPT / 256, 4, 44, 256, (G - 1) - bid}; pg8::EpiPartF32 Et{YS, DM, 256};
      pg8::gemm_phase<pg8::EpiPartF32, pg8::TailOrder, false, true>(lds, gt, T, Et); }
    xcd_barrier(xbar);
    for (int m0 = gw; m0 < MTOK; m0 += 4 * NGW) resid_rows<true, true, 4>(x_prompt, x_sample, XA, Y, YS, 11, args.in[17], 0.5f, out, XA, RS, m0, NGW, lane);
}

extern "C" void kernel_launch(void* const* d_in, const int* in_sizes, int n_in, void* d_out, int out_size, void* d_ws, size_t ws_size, hipStream_t stream) {
    static int grid = 0;
    if (grid == 0) {
        int dev = 0, cus = 0, per_cu = 0;
        (void)hipGetDevice(&dev);
        (void)hipDeviceGetAttribute(&cus, hipDeviceAttributeMultiprocessorCount, dev);
        (void)hipFuncSetAttribute((const void*)mk_fwd, hipFuncAttributeMaxDynamicSharedMemorySize, LDS_BYTES);
        if (hipOccupancyMaxActiveBlocksPerMultiprocessor(&per_cu, (const void*)mk_fwd, 512, LDS_BYTES) != hipSuccess || per_cu < 1) { fprintf(stderr, "occupancy query: %d blocks per CU\n", per_cu); per_cu = 1; }
        (void)hipGetLastError();
        grid = cus * (per_cu > 1 ? 1 : per_cu);
        if (n_in != 20 || ws_size < WS_END) { fprintf(stderr, "kernel_launch: unexpected inputs (n_in %d, ws %zu)\n", n_in, ws_size); grid = -1; }
    }
    if (grid < 0) return;
    if (hipMemsetAsync(d_ws, 0, XCD_BAR_WORDS * 4, stream) != hipSuccess) { fprintf(stderr, "kernel_launch: memset of the barrier words failed\n"); return; }
    Args a{};
    for (int i = 0; i < 20; ++i) a.in[i] = (const float*)d_in[i];
    a.out = (float*)d_out; a.ws = (unsigned char*)d_ws;
    void* kargs[] = {&a};
    hipError_t e = hipLaunchCooperativeKernel((const void*)mk_fwd, dim3(grid), dim3(512), kargs, LDS_BYTES, stream);
    if (e != hipSuccess) fprintf(stderr, "cooperative launch failed: %s (grid %d)\n", hipGetErrorString(e), grid);
}
```
